# Optimizing an MI355X kernel written in HIP

```python
import math
import jax, jax.numpy as jnp
from jax import lax
import numpy as np


D_MODEL = 1024
BATCH = 8
SEQ = 2048
DEPTH = 2

SSM_WIDTH = D_MODEL // 2
SSM_GROUP = 16
SSM_GROUPS = SSM_WIDTH // SSM_GROUP
SSM_STATE = 64
DT_MIN = 1e-3
DT_MAX = 1e-1
CONV_WIDTH = D_MODEL // 2
CONV_KERNEL = 31
POOL_WIDTH = D_MODEL // 2
POOL_WINDOWS = (2, 4, 8, 16)
POOL_GROUP = POOL_WIDTH // len(POOL_WINDOWS)
N_BRANCHES = 3
IN_WIDTH = SSM_WIDTH + 2 * CONV_WIDTH + POOL_WIDTH + N_BRANCHES * D_MODEL
FFN_HIDDEN = ((8 * D_MODEL + 3 * 256 - 1) // (3 * 256)) * 256
EPS = 1e-6

kernel_name = 'hybrid_s5_conformer_pool_gated_block'


def rms_norm(x, g):
    xf = x.astype(jnp.float32)
    y = xf * lax.rsqrt(jnp.mean(xf * xf, axis=-1, keepdims=True) + EPS)
    return (y * g.astype(jnp.float32)).astype(x.dtype)


def layer_norm(x, g, b):
    xf = x.astype(jnp.float32)
    mu = jnp.mean(xf, axis=-1, keepdims=True)
    var = jnp.mean(jnp.square(xf - mu), axis=-1, keepdims=True)
    y = (xf - mu) * lax.rsqrt(var + EPS)
    return (y * g.astype(jnp.float32) + b.astype(jnp.float32)).astype(x.dtype)


def _complex_linear_combine(e1, e2):
    a1r, a1i, b1r, b1i = e1
    a2r, a2i, b2r, b2i = e2
    return (a2r * a1r - a2i * a1i,
            a2r * a1i + a2i * a1r,
            a2r * b1r - a2i * b1i + b2r,
            a2r * b1i + a2i * b1r + b2i)


def s5_mixer(u, a_re, a_im, log_dt, b_re, b_im, c_re, c_im, d_skip, w_glu, b_glu):
    bsz, seq, _ = u.shape
    f32 = jnp.float32
    uf = u.astype(f32).reshape(bsz, seq, SSM_GROUPS, SSM_GROUP)
    a_re = a_re.astype(f32)
    a_im = a_im.astype(f32)
    dt = jnp.exp(log_dt.astype(f32))[:, None]
    mag = jnp.exp(dt * a_re)
    ang = dt * a_im
    abar_re = mag * jnp.cos(ang)
    abar_im = mag * jnp.sin(ang)
    den = a_re * a_re + a_im * a_im
    nr = abar_re - 1.0
    ni = abar_im
    f_re = (nr * a_re + ni * a_im) / den
    f_im = (ni * a_re - nr * a_im) / den
    b_re = b_re.astype(f32)
    b_im = b_im.astype(f32)
    bbar_re = f_re[..., None] * b_re - f_im[..., None] * b_im
    bbar_im = f_re[..., None] * b_im + f_im[..., None] * b_re
    bu_re = jnp.einsum('bsgp,gnp->bsgn', uf, bbar_re)
    bu_im = jnp.einsum('bsgp,gnp->bsgn', uf, bbar_im)
    a_seq_re = jnp.broadcast_to(abar_re, bu_re.shape)
    a_seq_im = jnp.broadcast_to(abar_im, bu_im.shape)
    _, _, h_re, h_im = lax.associative_scan(
        _complex_linear_combine, (a_seq_re, a_seq_im, bu_re, bu_im), axis=1)
    y = (jnp.einsum('bsgn,gpn->bsgp', h_re, c_re.astype(f32))
         - jnp.einsum('bsgn,gpn->bsgp', h_im, c_im.astype(f32))
         + d_skip.astype(f32) * uf)
    y = y.reshape(bsz, seq, SSM_WIDTH)
    g = jax.nn.gelu(y)
    out = g * jax.nn.sigmoid(g @ w_glu.astype(f32) + b_glu.astype(f32))
    return out.astype(u.dtype)


def conv_module(v, w_dw, b_dw, ln_g, ln_b, w_proj):
    h = v[..., :CONV_WIDTH] * jax.nn.sigmoid(v[..., CONV_WIDTH:])
    h = jnp.pad(h, ((0, 0), (CONV_KERNEL - 1, 0), (0, 0)))
    h = lax.conv_general_dilated(h, w_dw, window_strides=(1,), padding='VALID',
                                 dimension_numbers=('NWC', 'WIO', 'NWC'),
                                 feature_group_count=CONV_WIDTH) + b_dw
    h = jax.nn.silu(layer_norm(h, ln_g, ln_b))
    return h @ w_proj


def pool_mixer(u, w_group, scale, w_proj):
    bsz, seq, _ = u.shape
    uf = u.astype(jnp.float32).reshape(bsz, seq, len(POOL_WINDOWS), POOL_GROUP)
    cs = jnp.cumsum(uf, axis=1)
    pos = jnp.arange(1, seq + 1, dtype=jnp.float32)
    outs = []
    for k, w in enumerate(POOL_WINDOWS):
        c = cs[:, :, k]
        lagged = jnp.pad(c, ((0, 0), (w, 0), (0, 0)))[:, :seq]
        mean = (c - lagged) / jnp.minimum(pos, float(w))[None, :, None]
        outs.append(mean - uf[:, :, k])
    p = jnp.stack(outs, axis=2)
    p = jnp.einsum('bsgc,gcd->bsgd', p, w_group.astype(jnp.float32))
    p = p.reshape(bsz, seq, POOL_WIDTH) * scale.astype(jnp.float32)
    return p.astype(u.dtype) @ w_proj


def hybrid_layer(x, norm1, w_in, b_gate, a_re, a_im, log_dt, b_re, b_im, c_re, c_im,
                 d_skip, w_glu, b_glu, ssm_w_proj, conv_w_dw, conv_b_dw, conv_ln_g,
                 conv_ln_b, conv_w_proj, pool_w_group, pool_scale, pool_w_proj, w_out,
                 norm2, w_gate, w_up, w_down):
    bsz, seq, _ = x.shape
    h = rms_norm(x, norm1)
    z = h @ w_in
    o1 = SSM_WIDTH
    o2 = o1 + 2 * CONV_WIDTH
    o3 = o2 + POOL_WIDTH
    u_a = z[..., :o1]
    v_b = z[..., o1:o2]
    u_c = z[..., o2:o3]
    gates = jax.nn.sigmoid(z[..., o3:] + b_gate).reshape(bsz, seq, N_BRANCHES, D_MODEL)
    y_a = s5_mixer(u_a, a_re, a_im, log_dt, b_re, b_im, c_re, c_im, d_skip, w_glu, b_glu) @ ssm_w_proj
    y_b = conv_module(v_b, conv_w_dw, conv_b_dw, conv_ln_g, conv_ln_b, conv_w_proj)
    y_c = pool_mixer(u_c, pool_w_group, pool_scale, pool_w_proj)
    merged = gates[:, :, 0] * y_a + gates[:, :, 1] * y_b + gates[:, :, 2] * y_c
    x = x + merged @ w_out
    h = rms_norm(x, norm2)
    x = x + (jax.nn.silu(h @ w_gate) * (h @ w_up)) @ w_down
    return x


def setup_inputs(seed: int = 0) -> dict:
    key = jax.random.key(seed)
    ks = iter(jax.random.split(key, 40))
    f32 = jnp.float32

    def nrm(shape, scale):
        return jax.random.normal(next(ks), shape, f32) * scale

    L, D, G, N, P = DEPTH, D_MODEL, SSM_GROUPS, SSM_STATE, SSM_GROUP
    n_idx = jnp.arange(N, dtype=f32)
    inputs = {
        'x': nrm((BATCH, SEQ, D), 1.0),
        'norm1': 1.0 + nrm((L, D), 0.02),
        'w_in': nrm((L, D, IN_WIDTH), D ** -0.5),
        'b_gate': nrm((L, N_BRANCHES * D), 0.01),
        'ssm_a_re': -0.5 + nrm((L, G, N), 0.01),
        'ssm_a_im': math.pi * n_idx + nrm((L, G, N), 0.01),
        'ssm_log_dt': jax.random.uniform(next(ks), (L, G), f32,
                                         math.log(DT_MIN), math.log(DT_MAX)),
        'ssm_b_re': nrm((L, G, N, P), (2.0 * P) ** -0.5),
        'ssm_b_im': nrm((L, G, N, P), (2.0 * P) ** -0.5),
        'ssm_c_re': nrm((L, G, P, N), (2.0 * N) ** -0.5 * 4.0),
        'ssm_c_im': nrm((L, G, P, N), (2.0 * N) ** -0.5 * 4.0),
        'ssm_d': nrm((L, G, P), 1.0),
        'ssm_w_glu': nrm((L, SSM_WIDTH, SSM_WIDTH), SSM_WIDTH ** -0.5),
        'ssm_b_glu': nrm((L, SSM_WIDTH), 0.01),
        'ssm_w_proj': nrm((L, SSM_WIDTH, D), SSM_WIDTH ** -0.5),
        'conv_w_dw': nrm((L, CONV_KERNEL, 1, CONV_WIDTH), CONV_KERNEL ** -0.5),
        'conv_b_dw': nrm((L, CONV_WIDTH), 0.01),
        'conv_ln_g': 1.0 + nrm((L, CONV_WIDTH), 0.02),
        'conv_ln_b': nrm((L, CONV_WIDTH), 0.01),
        'conv_w_proj': nrm((L, CONV_WIDTH, D), CONV_WIDTH ** -0.5),
        'pool_w_group': nrm((L, len(POOL_WINDOWS), POOL_GROUP, POOL_GROUP), POOL_GROUP ** -0.5),
        'pool_scale': 1.0 + nrm((L, POOL_WIDTH), 0.02),
        'pool_w_proj': nrm((L, POOL_WIDTH, D), POOL_WIDTH ** -0.5),
        'w_out': nrm((L, D, D), D ** -0.5),
        'norm2': 1.0 + nrm((L, D), 0.02),
        'ffn_w_gate': nrm((L, D, FFN_HIDDEN), D ** -0.5),
        'ffn_w_up': nrm((L, D, FFN_HIDDEN), D ** -0.5),
        'ffn_w_down': nrm((L, FFN_HIDDEN, D), FFN_HIDDEN ** -0.5),
        'final_norm': 1.0 + nrm((D,), 0.02),
    }
    return inputs


def reference(x, norm1, w_in, b_gate, ssm_a_re, ssm_a_im, ssm_log_dt, ssm_b_re, ssm_b_im,
              ssm_c_re, ssm_c_im, ssm_d, ssm_w_glu, ssm_b_glu, ssm_w_proj, conv_w_dw,
              conv_b_dw, conv_ln_g, conv_ln_b, conv_w_proj, pool_w_group, pool_scale,
              pool_w_proj, w_out, norm2, ffn_w_gate, ffn_w_up, ffn_w_down, final_norm):
    for l in range(DEPTH):
        x = hybrid_layer(x, norm1[l], w_in[l], b_gate[l], ssm_a_re[l], ssm_a_im[l],
                         ssm_log_dt[l], ssm_b_re[l], ssm_b_im[l], ssm_c_re[l], ssm_c_im[l],
                         ssm_d[l], ssm_w_glu[l], ssm_b_glu[l], ssm_w_proj[l], conv_w_dw[l],
                         conv_b_dw[l], conv_ln_g[l], conv_ln_b[l], conv_w_proj[l],
                         pool_w_group[l], pool_scale[l], pool_w_proj[l], w_out[l], norm2[l],
                         ffn_w_gate[l], ffn_w_up[l], ffn_w_down[l])
    return rms_norm(x, final_norm)
```

```cpp
#include <hip/hip_runtime.h>
#include <cstdio>
#include <cstdint>

#define LAS __attribute__((address_space(3)))
typedef unsigned short bf16;
typedef short bf16x8 __attribute__((ext_vector_type(8)));
typedef float f32x4 __attribute__((ext_vector_type(4)));
typedef float f32x2 __attribute__((ext_vector_type(2)));
typedef unsigned u32x4 __attribute__((ext_vector_type(4)));
typedef unsigned u32x2 __attribute__((ext_vector_type(2)));

#ifndef MK_PER_PHASE
#define MK_PER_PHASE 0
#endif

constexpr int DM = 1024, BATCH = 8, SEQ = 2048, DEPTH = 2, M = BATCH * SEQ;
constexpr int SW = 512, NG = 32, NP = 16, NS = 64, CW = 512, CKW = 31, PW = 512, PGW = 128, INW = 5120, FF = 2816;
constexpr int CL = 16, NCHUNK = M / CL, CPB = SEQ / CL, XSK = 384;
constexpr float EPS = 1e-6f;
constexpr int NWAVES = 8, NTHR = 512;

constexpr size_t MiB = 1u << 20;
constexpr size_t WS_CTL = 0, CTL_ZERO_BYTES = 1 * MiB;
constexpr size_t WS_ROWSS = 1 * MiB;
constexpr size_t WS_LAM16 = WS_ROWSS + 5 * (size_t)M * 4;
constexpr size_t WS_CWT = WS_LAM16 + 16384;
constexpr size_t WS_WMIX = 2 * MiB;
constexpr size_t WS_WGATE = WS_WMIX + 4 * MiB;
constexpr size_t WS_WGLU = WS_WGATE + 6 * MiB;
constexpr size_t WS_WBR = WS_WGLU + MiB / 2;
constexpr size_t WS_WOUT = WS_WBR + 3 * MiB;
constexpr size_t WS_WGU = WS_WOUT + 2 * MiB;
constexpr size_t WS_WDN = WS_WGU + 11 * MiB;
constexpr size_t WS_WS = WS_WDN + 5 * MiB + MiB / 2;
constexpr size_t WS_TW = WS_WS + 4 * MiB;
constexpr size_t WS_XB = 44 * MiB;
constexpr size_t WS_RC = 76 * MiB;
constexpr size_t WS_G = WS_RC, WS_HID = WS_RC;
constexpr size_t WS_XS = WS_RC;
constexpr size_t WS_HC = WS_XS + 24 * MiB;
constexpr size_t WS_V = WS_HC + 16 * MiB;
constexpr size_t WS_S = WS_V + 16 * MiB;
constexpr size_t WS_YS = WS_S + 16 * MiB;
constexpr size_t WS_BR = 172 * MiB;
constexpr size_t WS_MG = 220 * MiB;
constexpr size_t WS_END = 252 * MiB;
static_assert(WS_TW + 6 * MiB <= WS_XB && WS_YS + 16 * MiB <= WS_RC + 96 * MiB && WS_CWT + 65536 <= WS_WMIX, "ws map");

constexpr int CW_BAR = 4096;

constexpr int RING_BYTES = 131072, LDSCTL_OFF = RING_BYTES, MISC_OFF = LDSCTL_OFF + 320, LDS_BYTES = 147456;

#define RLX_AGENT __ATOMIC_RELAXED, __HIP_MEMORY_SCOPE_AGENT
#define LDS_WAIT() asm volatile("s_waitcnt lgkmcnt(0)" ::: "memory")
#define VM_WAIT() asm volatile("s_waitcnt vmcnt(0)" ::: "memory")

__device__ __forceinline__ unsigned f2bf(float f) { unsigned u = __builtin_bit_cast(unsigned, f); return (u + 0x7fffu + ((u >> 16) & 1u)) >> 16; }
__device__ __forceinline__ unsigned pk2(float lo, float hi) { return f2bf(lo) | (f2bf(hi) << 16); }
__device__ __forceinline__ unsigned cvt_pk_bf16(float lo, float hi) { unsigned r; asm volatile("v_cvt_pk_bf16_f32 %0, %1, %2" : "=v"(r) : "v"(lo), "v"(hi)); return r; }
__device__ __forceinline__ float bf_lo(unsigned w) { return __builtin_bit_cast(float, w << 16); }
__device__ __forceinline__ float bf_hi(unsigned w) { return __builtin_bit_cast(float, w & 0xffff0000u); }
__device__ __forceinline__ float fsigmoid(float v) { return __builtin_amdgcn_rcpf(1.0f + __builtin_amdgcn_exp2f(-1.4426950408889634f * v)); }
__device__ __forceinline__ float fgelu(float v) { return v * fsigmoid(1.5957691216057308f * (v + 0.044715f * v * v * v)); }

#define XB_TMO      128
#define XB_XCNT(j)  (256  + 64 * (j))
#define XB_XSUB(j)  (1280 + 64 * (j))
#define XB_XGEN(j)  (2304 + 64 * (j))
#define XB_TOP      3328
#define XB_TOPGEN   3392
#define XCD_BAR_WORDS 3456
#define XB_SPIN_CAP (1u << 18)
__device__ __forceinline__ unsigned xb_ld(unsigned* p)              { return __hip_atomic_load(p, __ATOMIC_RELAXED, __HIP_MEMORY_SCOPE_AGENT); }
__device__ __forceinline__ unsigned xb_add(unsigned* p, unsigned v) { return __hip_atomic_fetch_add(p, v, __ATOMIC_RELAXED, __HIP_MEMORY_SCOPE_AGENT); }
__device__ __forceinline__ unsigned xb_xcc_id() { return (unsigned)__builtin_amdgcn_s_getreg((3 << 11) | 20) & 0xFu; }
#define XB_SPIN(cond, bar) do { unsigned _sp = 0; while (cond) { __builtin_amdgcn_s_sleep(1); \
    if ((++_sp & 255u) == 0u) { if (xb_ld(&(bar)[XB_TMO])) break; if (_sp > XB_SPIN_CAP) { atomicAdd(&(bar)[XB_TMO], 1u); break; } } } } while (0)
struct XcdBarrier { unsigned* bar; unsigned x; volatile LAS unsigned* st; };
__device__ __forceinline__ XcdBarrier xcd_barrier_post(unsigned* bar, volatile LAS unsigned* st) {
    XcdBarrier b; b.bar = bar; b.x = xb_xcc_id(); b.st = st;
    if (threadIdx.x == 0) (void)xb_add(&bar[XB_XCNT(b.x)], 1u);
    return b;
}
__device__ __forceinline__ void xcd_barrier_complete(unsigned* bar, unsigned x, unsigned& nloc, unsigned& nx) {
    const unsigned G = gridDim.x * gridDim.y * gridDim.z;
    unsigned sum, cnt, mine, sp = 0u;
    for (;;) {
        sum = 0u; cnt = 0u; mine = 0u;
#pragma unroll
        for (unsigned j = 0; j < 16; ++j) { const unsigned c = xb_ld(&bar[XB_XCNT(j)]); sum += c; cnt += (c > 0u) ? 1u : 0u; mine = (j == x) ? c : mine; }
        if (sum == G) break;
        __builtin_amdgcn_s_sleep(1);
        if ((++sp & 255u) == 0u) { if (xb_ld(&bar[XB_TMO])) break; if (sp > XB_SPIN_CAP) { atomicAdd(&bar[XB_TMO], 1u); break; } }
    }
    nloc = mine > 0u ? mine : 1u; nx = cnt > 0u ? cnt : 1u;
}
__device__ __forceinline__ void xcd_barrier(const XcdBarrier& b) {
    asm volatile("s_waitcnt vmcnt(0)" ::: "memory");
    __syncthreads();
    if (threadIdx.x == 0) {
        unsigned* bar = b.bar;
        __builtin_amdgcn_s_waitcnt(0);
        unsigned nloc = b.st[0], nx = b.st[1];
        if (nloc == 0u) { xcd_barrier_complete(bar, b.x, nloc, nx); b.st[0] = nloc; b.st[1] = nx; }
        const unsigned old = xb_add(&bar[XB_XSUB(b.x)], 1u);
        const unsigned gen = old / nloc;
        if (old + 1u == (gen + 1u) * nloc) {
            __builtin_amdgcn_fence(__ATOMIC_RELEASE, "agent");
            asm volatile("s_waitcnt vmcnt(0)" ::: "memory");
            const unsigned og = xb_add(&bar[XB_TOP], 1u);
            const unsigned tg = og / nx;
            if (og + 1u == (tg + 1u) * nx) xb_add(&bar[XB_TOPGEN], 1u);
            else XB_SPIN(xb_ld(&bar[XB_TOPGEN]) == tg, bar);
            __builtin_amdgcn_fence(__ATOMIC_ACQUIRE, "agent");
            xb_add(&bar[XB_XGEN(b.x)], 1u);
            asm volatile("s_waitcnt vmcnt(0)" ::: "memory");
        } else {
            XB_SPIN(xb_ld(&bar[XB_XGEN(b.x)]) == gen, bar);
            __builtin_amdgcn_fence(__ATOMIC_ACQUIRE, "agent");
            asm volatile("s_waitcnt vmcnt(0)" ::: "memory");
        }
    }
    __syncthreads();
}

struct Args { const float* in[29]; float* out; unsigned char* ws; int ph_lo, ph_hi; };

enum GemmMode { GM_MIX = 0, GM_S1, GM_S3, GM_GLU, GM_GATE, GM_MERGE, GM_WOUT, GM_GU, GM_DOWN };
struct GDesc {
    int mode; const char* A; const char* B; int lda, ldb, K, nM, nN;
    const float* rs_in;
    float* rs_out;
    const float* bias;
    const float* xold; float* xnew; bf16* xb;
    unsigned char* ws;
};
struct Unit { const char* A; const char* B; int pm, pn, aux; };

constexpr int BM = 256, BK = 64, HALF = 128, HTB = HALF * BK * 2, NXCD = 8, WGM = 8;
__device__ __forceinline__ int lds_byte(int r, int c) { const int st = (r >> 4) * 2 + (c >> 5), rr = r & 15, cc = c & 31, ob = rr * 64 + cc * 2; return st * 1024 + (ob ^ (((ob >> 9) & 1) << 5)); }
__device__ __forceinline__ void stage_rc(int b, int& R, int& C) { const int st = b / 1024, sb = b % 1024, swz = sb ^ (((sb >> 9) & 1) << 5); R = (st >> 1) * 16 + swz / 64; C = (st & 1) * 32 + (swz % 64) / 2; }
__device__ __forceinline__ int perm32(int rho) { const int n = rho >> 4, i = rho & 15; return 8 * (i >> 2) + 4 * n + (i & 3); }

template <int MODE> __device__ __forceinline__ bool sched_next(const GDesc& d, int G, int c, int i, Unit& u) {
    if (MODE == GM_S1 || MODE == GM_S3) {
        const int L = i * G + c; if (L >= 128) return false;
        const int g = L >> 2, r = L & 3;
        u.A = d.A + (size_t)(g * NCHUNK + r * 256) * d.lda * 2; u.B = d.B + (size_t)g * 256 * d.ldb * 2; u.pm = r; u.pn = 0; u.aux = g; return true;
    }
    int ii = i, sub = 0; if (MODE == GM_MERGE) { ii = i / 3; sub = i - 3 * ii; }
    const int nwg = d.nM * d.nN; const long L = (long)ii * G + c; if (L >= nwg) return false;
    int wgid = (int)L; { const int q = nwg / NXCD, r = nwg % NXCD, xcd = wgid % NXCD, off = wgid / NXCD; wgid = (xcd < r ? xcd * (q + 1) : r * (q + 1) + (xcd - r) * q) + off; }
    const int nig = WGM * d.nN, gid = wgid / nig, fm = gid * WGM, gsz = (d.nM - fm) < WGM ? (d.nM - fm) : WGM;
    u.pm = fm + ((wgid % nig) % gsz); u.pn = (wgid % nig) / gsz; u.aux = sub;
    u.A = d.A + (size_t)u.pm * 256 * d.lda * 2 + sub * 1024; u.B = d.B + (size_t)u.pn * 256 * d.ldb * 2 + sub * 1024; return true;
}

__device__ __forceinline__ void store8(bf16* p, const f32x4& v0, const f32x4& v1) {
    u32x4 w; w.x = cvt_pk_bf16(v0[0], v0[1]); w.y = cvt_pk_bf16(v0[2], v0[3]); w.z = cvt_pk_bf16(v1[0], v1[1]); w.w = cvt_pk_bf16(v1[2], v1[3]); *(u32x4*)p = w;
}
__device__ __forceinline__ void load8(const bf16* p, f32x4& v0, f32x4& v1) {
    const u32x4 w = *(const u32x4*)p; v0 = (f32x4){bf_lo(w.x), bf_hi(w.x), bf_lo(w.y), bf_hi(w.y)}; v1 = (f32x4){bf_lo(w.z), bf_hi(w.z), bf_lo(w.w), bf_hi(w.w)};
}
__device__ __forceinline__ f32x4 sig4(const f32x4& v) { return (f32x4){fsigmoid(v[0]), fsigmoid(v[1]), fsigmoid(v[2]), fsigmoid(v[3])}; }
__device__ __forceinline__ f32x4 rcp4(const f32x4& v) { return (f32x4){__builtin_amdgcn_rcpf(v[0]), __builtin_amdgcn_rcpf(v[1]), __builtin_amdgcn_rcpf(v[2]), __builtin_amdgcn_rcpf(v[3])}; }
__device__ __forceinline__ f32x4 gelu4(const f32x4& v) { return (f32x4){fgelu(v[0]), fgelu(v[1]), fgelu(v[2]), fgelu(v[3])}; }

template <int MODE> __device__ __forceinline__ bool epilogue(const GDesc& d, const Unit& u, f32x4 (&acc)[2][2][4][2], int wr, int wc, int fr, int fq) {
    constexpr int mode = MODE;
    unsigned char* ws = d.ws;
    const int rl0 = wr * 64 + fr;
    const int cl0 = wc * 32 + 8 * fq;
    if constexpr (mode == GM_MIX) {
        const int rowb = u.pm * BM + rl0;
        if (u.pn < 2) {
            bf16* XS = (bf16*)(ws + WS_XS);
#pragma unroll
            for (int ai = 0; ai < 2; ++ai)
#pragma unroll
                for (int m = 0; m < 4; ++m) { const int row = rowb + ai * HALF + m * 16; const float rs = __builtin_amdgcn_rsqf(d.rs_in[row] * (1.0f / DM) + EPS);
#pragma unroll
                    for (int bj = 0; bj < 2; ++bj) { const int ch = u.pn * BM + bj * HALF + cl0; const int g = ch >> 4, p0 = ch & 15;
                        store8(XS + ((size_t)(g * NCHUNK + (row >> 4)) * XSK + (row & 15) * 16 + p0), acc[ai][bj][m][0] * rs, acc[ai][bj][m][1] * rs); } }
        } else if (u.pn < 6) {
            bf16* HC = (bf16*)(ws + WS_HC);
#pragma unroll
            for (int ai = 0; ai < 2; ++ai)
#pragma unroll
                for (int m = 0; m < 4; ++m) { const int row = rowb + ai * HALF + m * 16; const float rs = __builtin_amdgcn_rsqf(d.rs_in[row] * (1.0f / DM) + EPS);
                    store8(HC + (size_t)row * CW + (u.pn - 2) * HALF + cl0, acc[ai][0][m][0] * rs * sig4(acc[ai][1][m][0] * rs), acc[ai][0][m][1] * rs * sig4(acc[ai][1][m][1] * rs)); }
        } else {
            bf16* V = (bf16*)(ws + WS_V);
#pragma unroll
            for (int ai = 0; ai < 2; ++ai)
#pragma unroll
                for (int m = 0; m < 4; ++m) { const int row = rowb + ai * HALF + m * 16; const float rs = __builtin_amdgcn_rsqf(d.rs_in[row] * (1.0f / DM) + EPS);
#pragma unroll
                    for (int bj = 0; bj < 2; ++bj) store8(V + (size_t)row * PW + (u.pn - 6) * BM + bj * HALF + cl0, acc[ai][bj][m][0] * rs, acc[ai][bj][m][1] * rs); }
        }
        return false;
    }
    if constexpr (mode == GM_GATE) {
        bf16* Gt = (bf16*)(ws + WS_G); const int rowb = u.pm * BM + rl0, colb = u.pn * BM + cl0;
        f32x4 bv[2][2];
#pragma unroll
        for (int bj = 0; bj < 2; ++bj)
#pragma unroll
            for (int n = 0; n < 2; ++n) bv[bj][n] = *(const f32x4*)(d.bias + colb + bj * HALF + 4 * n);
#pragma unroll
        for (int ai = 0; ai < 2; ++ai)
#pragma unroll
            for (int m = 0; m < 4; ++m) { const int row = rowb + ai * HALF + m * 16; const float rs = __builtin_amdgcn_rsqf(d.rs_in[row] * (1.0f / DM) + EPS);
#pragma unroll
                for (int bj = 0; bj < 2; ++bj) store8(Gt + (size_t)row * 3072 + colb + bj * HALF, sig4(acc[ai][bj][m][0] * rs + bv[bj][0]), sig4(acc[ai][bj][m][1] * rs + bv[bj][1])); }
        return false;
    }
    if constexpr (mode == GM_S1) {
        float* S = (float*)(ws + WS_S) + (size_t)(u.aux * NCHUNK + u.pm * BM) * 128;
#pragma unroll
        for (int ai = 0; ai < 2; ++ai)
#pragma unroll
            for (int m = 0; m < 4; ++m) { float* p = S + (size_t)(rl0 + ai * HALF + m * 16) * 128 + cl0; *(f32x4*)p = acc[ai][0][m][0]; *(f32x4*)(p + 4) = acc[ai][0][m][1]; }
        return false;
    }
    if constexpr (mode == GM_S3) {
        bf16* YS = (bf16*)(ws + WS_YS);
#pragma unroll
        for (int ai = 0; ai < 2; ++ai)
#pragma unroll
            for (int m = 0; m < 4; ++m) { const int chunk = u.pm * BM + rl0 + ai * HALF + m * 16;
#pragma unroll
                for (int bj = 0; bj < 2; ++bj) { const int col = bj * HALF + cl0; const int tok = chunk * CL + (col >> 4);
                    store8(YS + (size_t)tok * SW + u.aux * NP + (col & 15), gelu4(acc[ai][bj][m][0]), gelu4(acc[ai][bj][m][1])); } }
        return false;
    }
    if constexpr (mode == GM_GLU) {
        const bf16* YS = (const bf16*)(ws + WS_YS); bf16* BR = (bf16*)(ws + WS_BR); const int rowb = u.pm * BM + rl0, colb = u.pn * BM + cl0;
        f32x4 bv[2][2];
#pragma unroll
        for (int bj = 0; bj < 2; ++bj)
#pragma unroll
            for (int n = 0; n < 2; ++n) bv[bj][n] = *(const f32x4*)(d.bias + colb + bj * HALF + 4 * n);
#pragma unroll
        for (int ai = 0; ai < 2; ++ai)
#pragma unroll
            for (int m = 0; m < 4; ++m) { const int row = rowb + ai * HALF + m * 16;
#pragma unroll
                for (int bj = 0; bj < 2; ++bj) { f32x4 y0, y1; load8(YS + (size_t)row * SW + colb + bj * HALF, y0, y1);
                    store8(BR + (size_t)row * 1536 + colb + bj * HALF, y0 * sig4(acc[ai][bj][m][0] + bv[bj][0]), y1 * sig4(acc[ai][bj][m][1] + bv[bj][1])); } }
        return false;
    }
    if constexpr (mode == GM_MERGE) {
        const bf16* Gt = (const bf16*)(ws + WS_G); bf16* MG = (bf16*)(ws + WS_MG); const int rowb = u.pm * BM + rl0, colb = u.pn * BM + cl0, sub = u.aux;
#pragma unroll
        for (int ai = 0; ai < 2; ++ai)
#pragma unroll
            for (int m = 0; m < 4; ++m) { const int row = rowb + ai * HALF + m * 16;
#pragma unroll
                for (int bj = 0; bj < 2; ++bj) { const bf16* gp = Gt + (size_t)row * 3072 + sub * DM + colb + bj * HALF; f32x4 a0, a1; load8(gp, a0, a1);
                    if (sub < 2) { f32x4 b0, b1; load8(gp + DM, b0, b1); acc[ai][bj][m][0] *= a0 * rcp4(b0); acc[ai][bj][m][1] *= a1 * rcp4(b1); }
                    else store8(MG + (size_t)row * DM + colb + bj * HALF, acc[ai][bj][m][0] * a0, acc[ai][bj][m][1] * a1); } }
        return sub < 2;
    }
    if constexpr (mode == GM_WOUT || mode == GM_DOWN) {
        const int rowb = u.pm * BM + rl0, colb = u.pn * BM + cl0;
#pragma unroll
        for (int ai = 0; ai < 2; ++ai)
#pragma unroll
            for (int m = 0; m < 4; ++m) { const int row = rowb + ai * HALF + m * 16; float ss = 0.f;
#pragma unroll
                for (int bj = 0; bj < 2; ++bj) { const size_t o = (size_t)row * DM + colb + bj * HALF;
                    const f32x4 x0 = *(const f32x4*)(d.xold + o) + acc[ai][bj][m][0], x1 = *(const f32x4*)(d.xold + o + 4) + acc[ai][bj][m][1];
                    *(f32x4*)(d.xnew + o) = x0; *(f32x4*)(d.xnew + o + 4) = x1; store8(d.xb + o, x0, x1);
                    ss += (x0[0] * x0[0] + x0[1] * x0[1]) + (x0[2] * x0[2] + x0[3] * x0[3]) + (x1[0] * x1[0] + x1[1] * x1[1]) + (x1[2] * x1[2] + x1[3] * x1[3]); }
                ss += __shfl_xor(ss, 16); ss += __shfl_xor(ss, 32);
                if (fq == 0) atomicAdd(d.rs_out + row, ss); }
        return false;
    }
    if constexpr (mode == GM_GU) {
        bf16* HID = (bf16*)(ws + WS_HID); const int rowb = u.pm * BM + rl0;
#pragma unroll
        for (int ai = 0; ai < 2; ++ai)
#pragma unroll
            for (int m = 0; m < 4; ++m) { const int row = rowb + ai * HALF + m * 16; const float rs = __builtin_amdgcn_rsqf(d.rs_in[row] * (1.0f / DM) + EPS);
                const f32x4 g0 = acc[ai][0][m][0] * rs, g1 = acc[ai][0][m][1] * rs;
                store8(HID + (size_t)row * FF + u.pn * HALF + cl0, g0 * sig4(g0) * (acc[ai][1][m][0] * rs), g1 * sig4(g1) * (acc[ai][1][m][1] * rs)); }
        return false;
    }
}

template <int MODE> __device__ __forceinline__ void gemm_phase(LAS unsigned char* lds, const GDesc& g, int G, int c, int wave_id) {
    int lane = (int)__builtin_amdgcn_mbcnt_hi(~0u, __builtin_amdgcn_mbcnt_lo(~0u, 0u)); asm volatile("" : "+v"(lane));
    const int wid = wave_id, tid = wid * 64 + lane, wr = wid >> 2, wc = wid & 3, fr = lane & 15, fq = lane >> 4;
    const int K = g.K, nt = K / BK;
    unsigned voffA[2], voffB[2];
#pragma unroll
    for (int i = 0; i < 2; ++i) { int R, C; stage_rc(tid * 16 + i * 8192, R, C); const int Rb = (R & ~31) + perm32(R & 31);
        voffA[i] = (unsigned)(R * g.lda + C) * 2u; voffB[i] = (unsigned)(Rb * g.ldb + C) * 2u; }
    const size_t kstep = (size_t)(BK * 2);
    const size_t hstepA = (size_t)HALF * g.lda * 2, hstepB = (size_t)HALF * g.ldb * 2;
    const unsigned ldsw = (unsigned)wid * 1024u;
    const int aoff = lds_byte(wr * 64 + fr, fq * 8), boff = lds_byte(wc * 32 + fr, fq * 8);
#define PG8_SA(b, h) (((b) * 2 + (h)) * HTB)
#define PG8_SB(b, h) ((4 + (b) * 2 + (h)) * HTB)
#define PG8_STAGE(bufoff, gbase, voff) do { _Pragma("unroll") for (int _i = 0; _i < 2; ++_i) \
        __builtin_amdgcn_global_load_lds((const unsigned*)((const char*)(gbase) + (voff)[_i]), (LAS unsigned*)(lds + (bufoff) + ldsw + _i * 8192), 16, 0, 0); } while (0)
#define PG8_LDA(dst, b, h) do { _Pragma("unroll") for (int m = 0; m < 4; ++m) _Pragma("unroll") for (int k = 0; k < 2; ++k) dst[m][k] = *(const LAS bf16x8*)(lds + PG8_SA(b, h) + aoff + m * 2048 + k * 1024); } while (0)
#define PG8_LDB(dst, b, h) do { _Pragma("unroll") for (int n = 0; n < 2; ++n) _Pragma("unroll") for (int k = 0; k < 2; ++k) dst[n][k] = *(const LAS bf16x8*)(lds + PG8_SB(b, h) + boff + n * 2048 + k * 1024); } while (0)
#define PG8_MMA(ai, bj, At, Bt) do { __builtin_amdgcn_s_setprio(1); _Pragma("unroll") for (int m = 0; m < 4; ++m) _Pragma("unroll") for (int n = 0; n < 2; ++n) _Pragma("unroll") for (int k = 0; k < 2; ++k) \
        acc[ai][bj][m][n] = __builtin_amdgcn_mfma_f32_16x16x32_bf16(Bt[n][k], At[m][k], acc[ai][bj][m][n], 0, 0, 0); __builtin_amdgcn_s_setprio(0); } while (0)
#define PG8_WAIT_V(n) asm volatile("s_waitcnt vmcnt(" #n ")" ::: "memory")
#define PG8_WAIT_L(n) asm volatile("s_waitcnt lgkmcnt(" #n ")" ::: "memory")
#define PG8_BAR __builtin_amdgcn_s_barrier()
#define PG8_SCHED __builtin_amdgcn_sched_barrier(0)
    Unit cur, nxt; int ui = 0;
    if (!sched_next<MODE>(g, G, c, 0, cur)) return;
    f32x4 acc[2][2][4][2];
#pragma unroll
    for (int a = 0; a < 2; ++a)
#pragma unroll
        for (int b = 0; b < 2; ++b)
#pragma unroll
            for (int m = 0; m < 4; ++m)
#pragma unroll
                for (int n = 0; n < 2; ++n) acc[a][b][m][n] = (f32x4){0.f, 0.f, 0.f, 0.f};
    bf16x8 At[4][2], B0[2][2], B1[2][2];
    const char* cA = cur.A; const char* cB = cur.B;
    PG8_STAGE(PG8_SB(0, 0), cB, voffB); PG8_STAGE(PG8_SB(0, 1), cB + hstepB, voffB); PG8_STAGE(PG8_SA(0, 0), cA, voffA); PG8_STAGE(PG8_SA(0, 1), cA + hstepA, voffA);
    if (wr == 1) PG8_BAR;
    PG8_WAIT_V(2); PG8_BAR;
    PG8_STAGE(PG8_SB(1, 0), cB + kstep, voffB); PG8_STAGE(PG8_SA(1, 0), cA + kstep, voffA); PG8_STAGE(PG8_SB(1, 1), cB + hstepB + kstep, voffB);
    PG8_WAIT_V(6); PG8_BAR;
    for (;;) {
        const bool has_next = sched_next<MODE>(g, G, c, ui + 1, nxt);
        const char* nA = has_next ? nxt.A : cA; const char* nB = has_next ? nxt.B : cB;
        for (int t = 0; t < nt; t += 2) {
            const bool last = (t == nt - 2);
            const char* a1 = cA + (size_t)(t + 1) * kstep;
            const char* a2 = last ? nA : cA + (size_t)(t + 2) * kstep; const char* b2 = last ? nB : cB + (size_t)(t + 2) * kstep;
            const char* a3 = a2 + kstep; const char* b3 = b2 + kstep;
            PG8_LDB(B0, 0, 0); PG8_LDB(B1, 0, 1); PG8_SCHED; PG8_LDA(At, 0, 0); PG8_STAGE(PG8_SA(1, 1), a1 + hstepA, voffA);
            PG8_WAIT_V(8); PG8_WAIT_L(0); PG8_BAR; PG8_MMA(0, 0, At, B0); PG8_MMA(0, 1, At, B1); PG8_BAR; PG8_SCHED;
            PG8_LDA(At, 0, 1); PG8_STAGE(PG8_SB(0, 0), b2, voffB); PG8_STAGE(PG8_SB(0, 1), b2 + hstepB, voffB); PG8_STAGE(PG8_SA(0, 0), a2, voffA);
            PG8_WAIT_V(8); PG8_WAIT_L(0); PG8_BAR; PG8_MMA(1, 0, At, B0); PG8_MMA(1, 1, At, B1); PG8_BAR; PG8_SCHED;
            PG8_LDB(B0, 1, 0); PG8_LDB(B1, 1, 1); PG8_SCHED; PG8_LDA(At, 1, 0); PG8_STAGE(PG8_SA(0, 1), a2 + hstepA, voffA);
            PG8_WAIT_V(8); PG8_WAIT_L(0); PG8_BAR; PG8_MMA(0, 0, At, B0); PG8_MMA(0, 1, At, B1); PG8_BAR; PG8_SCHED;
            PG8_LDA(At, 1, 1); PG8_STAGE(PG8_SB(1, 0), b3, voffB); PG8_STAGE(PG8_SB(1, 1), b3 + hstepB, voffB); PG8_STAGE(PG8_SA(1, 0), a3, voffA);
            PG8_WAIT_V(8); PG8_WAIT_L(0); PG8_BAR; PG8_MMA(1, 0, At, B0); PG8_MMA(1, 1, At, B1); PG8_BAR; PG8_SCHED;
        }
        if (wr == 0) PG8_BAR;
        const bool keep = epilogue<MODE>(g, cur, acc, wr, wc, fr, fq);
        if (!has_next) break;
        if (!keep) {
#pragma unroll
            for (int a = 0; a < 2; ++a)
#pragma unroll
                for (int b = 0; b < 2; ++b)
#pragma unroll
                    for (int m = 0; m < 4; ++m)
#pragma unroll
                        for (int n = 0; n < 2; ++n) acc[a][b][m][n] = (f32x4){0.f, 0.f, 0.f, 0.f};
        }
        cur = nxt; cA = nA; cB = nB; ++ui;
        if (wr == 1) PG8_BAR;
    }
    PG8_WAIT_V(0);
    PG8_BAR;
#undef PG8_SA
#undef PG8_SB
#undef PG8_STAGE
#undef PG8_LDA
#undef PG8_LDB
#undef PG8_MMA
#undef PG8_WAIT_V
#undef PG8_WAIT_L
#undef PG8_BAR
#undef PG8_SCHED
}

typedef const float* const __attribute__((address_space(4))) * KargPtr;
struct InTab { KargPtr kp; __device__ __forceinline__ const float* operator[](int i) const { return kp[i]; } };
#define ARG_IN(i) (F.in[(i)])
struct Frame { LAS unsigned char* lds; int tid, lane, wave, vcu, G; InTab in; float* out; unsigned char* ws; };

__device__ __forceinline__ float wave_sum(float v) {
#pragma unroll
    for (int o = 1; o < 64; o <<= 1) v += __shfl_xor(v, o);
    return v;
}
__device__ __forceinline__ void transpose_item(const float* W, int ldw, int col0, int k0, const float* gain, bf16* dst, int ldd, LAS float* scr, int lane) {
#pragma unroll 8
    for (int i = 0; i < 32; ++i) { const int kk = 2 * i + (lane >> 5); float v = W[(size_t)(k0 + kk) * ldw + col0 + (lane & 31)]; if (gain) v *= gain[k0 + kk]; scr[kk * 33 + (lane & 31)] = v; }
    LDS_WAIT(); asm volatile("" ::: "memory");
    const int c = lane & 7;
#pragma unroll
    for (int j = 0; j < 4; ++j) { const int n = (lane >> 3) + 8 * j; const LAS float* s = scr + (8 * c) * 33 + n;
        u32x4 o; o.x = pk2(s[0 * 33], s[1 * 33]); o.y = pk2(s[2 * 33], s[3 * 33]); o.z = pk2(s[4 * 33], s[5 * 33]); o.w = pk2(s[6 * 33], s[7 * 33]);
        *(u32x4*)(dst + (size_t)n * ldd + k0 + 8 * c) = o; }
    LDS_WAIT(); asm volatile("" ::: "memory");
}

__device__ __forceinline__ void s5_group_prep(Frame& F, int l, int g) {
    LAS float* LPr = (LAS float*)F.lds;
    LAS float* LPi = LPr + 17 * 64;
    LAS float* BBr = LPi + 17 * 64;
    LAS float* BBi = BBr + 1024;
    LAS float* Cr = BBi + 1024;
    LAS float* Ci = Cr + 1024;
    LAS float* Kt = Ci + 1024;
    LAS float* Dk = Kt + 4096;
    const float* a_re = F.in[4] + (size_t)(l * NG + g) * NS; const float* a_im = F.in[5] + (size_t)(l * NG + g) * NS; const float log_dt = F.in[6][l * NG + g];
    const float* b_re = F.in[7] + (size_t)(l * NG + g) * NS * NP; const float* b_im = F.in[8] + (size_t)(l * NG + g) * NS * NP;
    const float* c_re = F.in[9] + (size_t)(l * NG + g) * NP * NS; const float* c_im = F.in[10] + (size_t)(l * NG + g) * NP * NS; const float* dsk = F.in[11] + (size_t)(l * NG + g) * NP;
    const double dt = exp((double)log_dt);
    for (int idx = F.tid; idx < 17 * 64; idx += NTHR) { const int tau = idx >> 6, n = idx & 63;
        const double mag = exp((double)tau * dt * (double)a_re[n]), ang = (double)tau * dt * (double)a_im[n];
        const double angr = ang - 6.283185307179586476925 * rint(ang * 0.15915494309189533577);
        LPr[idx] = (float)(mag * (double)cosf((float)angr)); LPi[idx] = (float)(mag * (double)sinf((float)angr)); }
    for (int idx = F.tid; idx < 1024; idx += NTHR) { const int n = idx >> 4;
        const double ar = a_re[n], ai = a_im[n], mag = exp(dt * ar), ang = dt * ai, angr = ang - 6.283185307179586476925 * rint(ang * 0.15915494309189533577);
        const double abr = mag * (double)cosf((float)angr), abi = mag * (double)sinf((float)angr), den = ar * ar + ai * ai, nr = abr - 1.0, ni = abi;
        const double fr = (nr * ar + ni * ai) / den, fi = (ni * ar - nr * ai) / den, br = b_re[idx], bi = b_im[idx];
        BBr[idx] = (float)(fr * br - fi * bi); BBi[idx] = (float)(fr * bi + fi * br);
        Cr[idx] = c_re[idx]; Ci[idx] = c_im[idx]; }
    if (F.tid < 16) Dk[F.tid] = dsk[F.tid];
    __syncthreads();
    for (int idx = F.tid; idx < 4096; idx += NTHR) { const int tau = idx >> 8, q = (idx >> 4) & 15, p = idx & 15; float s = 0.f;
        for (int n = 0; n < 64; ++n) { const float cr = Cr[q * 64 + n], ci = Ci[q * 64 + n], lr = LPr[tau * 64 + n], li = LPi[tau * 64 + n], xr = cr * lr - ci * li, xi = cr * li + ci * lr;
            s += xr * BBr[n * 16 + p] - xi * BBi[n * 16 + p]; }
        Kt[idx] = s; }
    __syncthreads();
    bf16* TW = (bf16*)(F.ws + WS_TW) + (size_t)g * 256 * XSK;
    for (int pc = F.tid; pc < 256 * 48; pc += NTHR) { const int row = pc / 48, k8 = (pc % 48) * 8, i = row >> 4, q = row & 15; float v[8];
        if (k8 < 256) { const int j = k8 >> 4, p0 = k8 & 15;
#pragma unroll
            for (int e = 0; e < 8; ++e) { float x = 0.f; if (j <= i) { x = Kt[((i - j) * 16 + q) * 16 + p0 + e]; if (i == j && p0 + e == q) x += Dk[q]; } v[e] = x; }
        } else { const int part = (k8 - 256) >> 6, n0 = (k8 - 256) & 63;
#pragma unroll
            for (int e = 0; e < 8; ++e) { const int n = n0 + e; const float cr = Cr[q * 64 + n], ci = Ci[q * 64 + n], lr = LPr[(i + 1) * 64 + n], li = LPi[(i + 1) * 64 + n];
                v[e] = part == 0 ? (cr * lr - ci * li) : -(cr * li + ci * lr); } }
        u32x4 o; o.x = pk2(v[0], v[1]); o.y = pk2(v[2], v[3]); o.z = pk2(v[4], v[5]); o.w = pk2(v[6], v[7]);
        *(u32x4*)(TW + (size_t)row * XSK + k8) = o; }
    bf16* WS = (bf16*)(F.ws + WS_WS) + (size_t)g * 256 * 256;
    for (int pc = F.tid; pc < 256 * 32; pc += NTHR) { const int row = pc >> 5, k8 = (pc & 31) * 8, j = k8 >> 4, p0 = k8 & 15; float v[8];
#pragma unroll
        for (int e = 0; e < 8; ++e) { float x = 0.f;
            if (row < 128) { const int n = row & 63; const float lr = LPr[(15 - j) * 64 + n], li = LPi[(15 - j) * 64 + n], br = BBr[n * 16 + p0 + e], bi = BBi[n * 16 + p0 + e];
                x = row < 64 ? (lr * br - li * bi) : (lr * bi + li * br); }
            v[e] = x; }
        u32x4 o; o.x = pk2(v[0], v[1]); o.y = pk2(v[2], v[3]); o.z = pk2(v[4], v[5]); o.w = pk2(v[6], v[7]);
        *(u32x4*)(WS + (size_t)row * 256 + k8) = o; }
    float* LAM = (float*)(F.ws + WS_LAM16) + (size_t)g * 128;
    if (F.tid < 64) { LAM[F.tid * 2] = LPr[16 * 64 + F.tid]; LAM[F.tid * 2 + 1] = LPi[16 * 64 + F.tid]; }
    __syncthreads();
}

__device__ __forceinline__ void pool_fold_item(Frame& F, int l, int item) {
    const int kk = item >> 4, k0 = (item & 15) * 64;
    LAS float* Wi = (LAS float*)F.lds;
    LAS float* Wg = Wi + 64 * 129;
    LAS bf16* To = (LAS bf16*)(Wg + 128 * 128);
    const float* w_in = F.in[2] + (size_t)l * DM * INW; const float* wgrp = F.in[20] + (size_t)(l * 4 + kk) * PGW * PGW; const float* norm1 = F.in[1] + (size_t)l * DM;
    for (int i = F.tid; i < 64 * 128; i += NTHR) { const int r = i >> 7, cc = i & 127; Wi[r * 129 + cc] = w_in[(size_t)(k0 + r) * INW + 1536 + kk * PGW + cc]; }
    for (int i = F.tid; i < 128 * 128; i += NTHR) Wg[i] = wgrp[i];
    __syncthreads();
    const int k = F.tid >> 3, jg = F.tid & 7; float acc[16];
#pragma unroll
    for (int e = 0; e < 16; ++e) acc[e] = 0.f;
    for (int i = 0; i < 128; ++i) { const float a = Wi[k * 129 + i];
#pragma unroll
        for (int e = 0; e < 16; ++e) acc[e] += a * Wg[i * 128 + jg * 16 + e]; }
    const float gn = norm1[k0 + k];
#pragma unroll
    for (int e = 0; e < 16; ++e) To[(jg * 16 + e) * 72 + k] = (bf16)f2bf(acc[e] * gn);
    __syncthreads();
    bf16* dst = (bf16*)(F.ws + WS_WMIX) + (size_t)(1536 + kk * PGW) * DM + k0;
    for (int pc = F.tid; pc < 128 * 8; pc += NTHR) { const int j = pc >> 3, c8 = (pc & 7) * 8; *(u32x4*)(dst + (size_t)j * DM + c8) = *(const LAS u32x4*)(To + j * 72 + c8); }
    __syncthreads();
}

__device__ __forceinline__ void prep_phase(Frame& F, int l) {
    const InTab in = F.in;
    for (int it = F.vcu; it < 96; it += F.G) { if (it < 32) s5_group_prep(F, l, it); else pool_fold_item(F, l, it - 32); }
    __syncthreads();
    LAS float* scr = (LAS float*)(F.lds + F.wave * 16384);
    const int gw = F.vcu * NWAVES + F.wave, NGW = F.G * NWAVES;
    const float* norm1 = in[1] + (size_t)l * DM; const float* norm2 = in[24] + (size_t)l * DM;
    const float* w_in = in[2] + (size_t)l * DM * INW;
    constexpr int R1 = 768, R2 = R1 + 1536, R3 = R2 + 128, R4 = R3 + 768, R5 = R4 + 512, R6 = R5 + 2816, R7 = R6 + 1408;
    for (int it = gw; it < R7; it += NGW) {
        if (it < R1) {
            const int blk = it >> 6, r = it & 63, kb = r >> 2, nb = r & 3;
            int col0; if (blk < 4) col0 = blk * 128; else { const int t = (blk - 4) >> 1, gt = (blk - 4) & 1; col0 = 512 + gt * 512 + t * 128; }
            transpose_item(w_in, INW, col0 + nb * 32, kb * 64, norm1, (bf16*)(F.ws + WS_WMIX) + (size_t)(blk * 128 + nb * 32) * DM, DM, scr, F.lane);
        } else if (it < R2) { const int r = it - R1, blk = r >> 6, q = r & 63, kb = q >> 2, nb = q & 3;
            transpose_item(w_in, INW, 2048 + blk * 128 + nb * 32, kb * 64, norm1, (bf16*)(F.ws + WS_WGATE) + (size_t)(blk * 128 + nb * 32) * DM, DM, scr, F.lane);
        } else if (it < R3) { const int r = it - R2, blk = r >> 5, q = r & 31, kb = q >> 2, nb = q & 3;
            transpose_item(in[12] + (size_t)l * SW * SW, SW, blk * 128 + nb * 32, kb * 64, nullptr, (bf16*)(F.ws + WS_WGLU) + (size_t)(blk * 128 + nb * 32) * SW, SW, scr, F.lane);
        } else if (it < R4) { const int r = it - R3, src = r >> 8, r2 = r & 255, blk = r2 >> 5, q = r2 & 31, kb = q >> 2, nb = q & 3;
            const float* W = (src == 0 ? in[14] : src == 1 ? in[19] : in[22]) + (size_t)l * 512 * DM;
            transpose_item(W, DM, blk * 128 + nb * 32, kb * 64, nullptr, (bf16*)(F.ws + WS_WBR) + (size_t)(blk * 128 + nb * 32) * 1536 + src * 512, 1536, scr, F.lane);
        } else if (it < R5) { const int r = it - R4, blk = r >> 6, q = r & 63, kb = q >> 2, nb = q & 3;
            transpose_item(in[23] + (size_t)l * DM * DM, DM, blk * 128 + nb * 32, kb * 64, nullptr, (bf16*)(F.ws + WS_WOUT) + (size_t)(blk * 128 + nb * 32) * DM, DM, scr, F.lane);
        } else if (it < R6) { const int r = it - R5, blk = r >> 6, q = r & 63, kb = q >> 2, nb = q & 3;
            const float* W = ((blk & 1) ? in[26] : in[25]) + (size_t)l * DM * FF;
            transpose_item(W, FF, (blk >> 1) * 128 + nb * 32, kb * 64, norm2, (bf16*)(F.ws + WS_WGU) + (size_t)(blk * 128 + nb * 32) * DM, DM, scr, F.lane);
        } else { const int r = it - R6, blk = r / 176, q = r % 176, kb = q >> 2, nb = q & 3;
            transpose_item(in[27] + (size_t)l * FF * DM, DM, blk * 128 + nb * 32, kb * 64, nullptr, (bf16*)(F.ws + WS_WDN) + (size_t)(blk * 128 + nb * 32) * FF, FF, scr, F.lane);
        }
    }
    { const float* wdw = in[15] + (size_t)l * CKW * CW; float* cwt = (float*)(F.ws + WS_CWT);
      for (int i = F.vcu * NTHR + F.tid; i < CW * 32; i += F.G * NTHR) { const int c = i >> 5, k = i & 31; cwt[i] = (k < CKW) ? wdw[k * CW + c] : 0.f; } }
    if (l == 0) {
        float* rowss = (float*)(F.ws + WS_ROWSS); bf16* XB = (bf16*)(F.ws + WS_XB); const float* x = in[0];
        for (int m = gw; m < M; m += NGW) {
            const f32x4* xr = (const f32x4*)(x + (size_t)m * DM) + F.lane; f32x4 v[4]; float s = 0.f;
#pragma unroll
            for (int j = 0; j < 4; ++j) { v[j] = xr[64 * j]; s += (v[j].x * v[j].x + v[j].y * v[j].y) + (v[j].z * v[j].z + v[j].w * v[j].w); }
            s = wave_sum(s);
            unsigned long long* o8 = (unsigned long long*)(XB + (size_t)m * DM) + F.lane;
#pragma unroll
            for (int j = 0; j < 4; ++j) o8[64 * j] = (unsigned long long)pk2(v[j].x, v[j].y) | ((unsigned long long)pk2(v[j].z, v[j].w) << 32);
            if (F.lane == 0) rowss[m] = s;
        }
        for (int i = (F.vcu * NTHR + F.tid); i < 4 * M; i += F.G * NTHR) rowss[M + i] = 0.f;
    }
}

__device__ __forceinline__ void mixer_tile(Frame& F, int l, int tile) {
    const int t0 = tile * 64, s0 = t0 & (SEQ - 1);
    const bf16* HC = (const bf16*)(F.ws + WS_HC); const bf16* V = (const bf16*)(F.ws + WS_V); bf16* BR = (bf16*)(F.ws + WS_BR);
    LAS unsigned char* hb = F.lds;
    LAS float* red = (LAS float*)(F.lds + 98304);
    for (int pc = F.tid; pc < 94 * 64; pc += NTHR) { const int r = pc >> 6, c16 = pc & 63; u32x4 v = (u32x4){0u, 0u, 0u, 0u};
        if (s0 - 30 + r >= 0) v = *(const u32x4*)(HC + (size_t)(t0 - 30 + r) * CW + c16 * 8);
        *(LAS u32x4*)(hb + r * 1024 + c16 * 16) = v; }
    __syncthreads();
    const int cp = F.tid & 255, th = F.tid >> 8, wv = F.wave & 3;
    float w0[32], w1[32];
    { const f32x4* wp = (const f32x4*)((const float*)(F.ws + WS_CWT) + (size_t)cp * 64);
#pragma unroll
      for (int k4 = 0; k4 < 8; ++k4) { const f32x4 a = wp[k4], b = wp[8 + k4]; w0[4 * k4] = a[0]; w0[4 * k4 + 1] = a[1]; w0[4 * k4 + 2] = a[2]; w0[4 * k4 + 3] = a[3];
          w1[4 * k4] = b[0]; w1[4 * k4 + 1] = b[1]; w1[4 * k4 + 2] = b[2]; w1[4 * k4 + 3] = b[3]; } }
    const f32x2 bdw = *(const f32x2*)(F.in[16] + (size_t)l * CW + 2 * cp);
    const f32x2 lng = *(const f32x2*)(F.in[17] + (size_t)l * CW + 2 * cp), lnb = *(const f32x2*)(F.in[18] + (size_t)l * CW + 2 * cp);
#pragma unroll 1
    for (int rr = 0; rr < 4; ++rr) {
        const int tb = (th * 4 + rr) * 8;
        float a0[8], a1[8];
#pragma unroll
        for (int i = 0; i < 8; ++i) { a0[i] = bdw.x; a1[i] = bdw.y; }
#pragma unroll
        for (int r = 0; r < 38; ++r) { const unsigned w = *(const LAS unsigned*)(hb + (tb + r) * 1024 + cp * 4); const float h0 = bf_lo(w), h1 = bf_hi(w);
#pragma unroll
            for (int i = 0; i < 8; ++i) { const int k = r - i; if (k >= 0 && k < CKW) { a0[i] += w0[k] * h0; a1[i] += w1[k] * h1; } } }
#pragma unroll
        for (int i = 0; i < 8; ++i) { float s = a0[i] + a1[i], q = a0[i] * a0[i] + a1[i] * a1[i]; s = wave_sum(s); q = wave_sum(q);
            if (F.lane == 0) { const int tok = tb + i; red[(tok * 4 + wv) * 2] = s; red[(tok * 4 + wv) * 2 + 1] = q; } }
        __syncthreads();
#pragma unroll
        for (int i = 0; i < 8; ++i) { const int tok = tb + i; const LAS float* rp = red + tok * 8;
            const float s = (rp[0] + rp[2]) + (rp[4] + rp[6]), q = (rp[1] + rp[3]) + (rp[5] + rp[7]);
            const float mu = s * (1.0f / CW), var = q * (1.0f / CW) - mu * mu, rstd = __builtin_amdgcn_rsqf(fmaxf(var, 0.f) + EPS);
            float y0 = (a0[i] - mu) * rstd * lng.x + lnb.x, y1 = (a1[i] - mu) * rstd * lng.y + lnb.y; y0 *= fsigmoid(y0); y1 *= fsigmoid(y1);
            *(unsigned*)(BR + (size_t)(t0 + tok) * 1536 + 512 + 2 * cp) = pk2(y0, y1); }
    }
    __syncthreads();
    for (int pc = F.tid; pc < 79 * 64; pc += NTHR) { const int r = pc >> 6, c16 = pc & 63; u32x4 v = (u32x4){0u, 0u, 0u, 0u};
        if (s0 - 15 + r >= 0) v = *(const u32x4*)(V + (size_t)(t0 - 15 + r) * PW + c16 * 8);
        *(LAS u32x4*)(hb + r * 1024 + c16 * 16) = v; }
    __syncthreads();
    {
        const int w = 2 << (cp >> 6); const f32x2 sc = *(const f32x2*)(F.in[21] + (size_t)l * PW + 2 * cp);
        const int i0 = th * 32; float sm0 = 0.f, sm1 = 0.f;
        for (int tau = 1; tau < w; ++tau) { const unsigned x = *(const LAS unsigned*)(hb + (i0 + 15 - tau) * 1024 + cp * 4); sm0 += bf_lo(x); sm1 += bf_hi(x); }
        for (int i = 0; i < 32; ++i) { const int tok = i0 + i; const unsigned x = *(const LAS unsigned*)(hb + (tok + 15) * 1024 + cp * 4); const float v0 = bf_lo(x), v1 = bf_hi(x);
            sm0 += v0; sm1 += v1;
            const int pos = s0 + tok + 1; const float inv = 1.0f / (float)(pos < w ? pos : w);
            *(unsigned*)(BR + (size_t)(t0 + tok) * 1536 + 1024 + 2 * cp) = pk2(sc.x * (sm0 * inv - v0), sc.y * (sm1 * inv - v1));
            const unsigned xo = *(const LAS unsigned*)(hb + (tok + 15 - (w - 1)) * 1024 + cp * 4); sm0 -= bf_lo(xo); sm1 -= bf_hi(xo); }
    }
    __syncthreads();
}

__device__ __forceinline__ void carry_phase(Frame& F) {
    const int gt = F.vcu * NTHR + F.tid; if (gt >= BATCH * NG * NS) return;
    const int b = gt >> 11, g = (gt >> 6) & 31, n = gt & 63;
    const float* LAM = (const float*)(F.ws + WS_LAM16) + (size_t)g * 128; const float lr = LAM[2 * n], li = LAM[2 * n + 1];
    const float* S = (const float*)(F.ws + WS_S) + (size_t)(g * NCHUNK + b * CPB) * 128 + n;
    bf16* XS = (bf16*)(F.ws + WS_XS) + (size_t)(g * NCHUNK + b * CPB) * XSK + 256 + n;
    float hr = 0.f, hi = 0.f;
    for (int c0 = 0; c0 < CPB; c0 += 16) {
        float sr[16], si[16];
#pragma unroll
        for (int e = 0; e < 16; ++e) { sr[e] = S[(size_t)(c0 + e) * 128]; si[e] = S[(size_t)(c0 + e) * 128 + 64]; }
#pragma unroll
        for (int e = 0; e < 16; ++e) { XS[(size_t)(c0 + e) * XSK] = (bf16)f2bf(hr); XS[(size_t)(c0 + e) * XSK + 64] = (bf16)f2bf(hi);
            const float nr = lr * hr - li * hi + sr[e], ni = lr * hi + li * hr + si[e]; hr = nr; hi = ni; }
    }
}

__device__ __forceinline__ void final_phase(Frame& F) {
    const float* rowss = (const float*)(F.ws + WS_ROWSS) + 4 * (size_t)M; const float* gfin = F.in[28];
    const int gw = F.vcu * NWAVES + F.wave, NGW = F.G * NWAVES;
    for (int m = gw; m < M; m += NGW) { const float rs = __builtin_amdgcn_rsqf(rowss[m] * (1.0f / DM) + EPS);
        f32x4* xr = (f32x4*)(F.out + (size_t)m * DM) + F.lane; const f32x4* gr = (const f32x4*)gfin + F.lane;
#pragma unroll
        for (int j = 0; j < 4; ++j) xr[64 * j] = xr[64 * j] * rs * gr[64 * j]; }
}

constexpr int PH_PER_LAYER = 11, PH_FINAL = PH_PER_LAYER * DEPTH, PH_TOTAL = PH_FINAL + 1;
__global__ void __launch_bounds__(NTHR, 2) mk_fwd(Args args) {
    extern __shared__ __attribute__((aligned(16))) unsigned char lds_raw[];
    Frame F; F.lds = (LAS unsigned char*)lds_raw; F.tid = threadIdx.x; F.lane = F.tid & 63; F.wave = __builtin_amdgcn_readfirstlane(F.tid >> 6);
    F.G = gridDim.x; { const int bx = blockIdx.x; F.vcu = (F.G % 8 == 0) ? (bx % 8) * (F.G / 8) + bx / 8 : bx; }
    F.out = args.out; F.ws = args.ws;
    unsigned char* ws = args.ws;
    volatile LAS unsigned* MISC = (volatile LAS unsigned*)(F.lds + MISC_OFF);
    for (int u = F.tid; u < (LDS_BYTES - LDSCTL_OFF) / 4; u += NTHR) ((LAS unsigned*)(F.lds + LDSCTL_OFF))[u] = 0u;
    __syncthreads();
    XcdBarrier bar; bar.bar = (unsigned*)(ws + WS_CTL) + CW_BAR; bar.x = 0; bar.st = nullptr;
    const bool multi = (args.ph_hi - args.ph_lo) > 1;
    if (multi) bar = xcd_barrier_post((unsigned*)(ws + WS_CTL) + CW_BAR, MISC + 8);
    const int wave0 = F.wave, vcu0 = F.vcu, G0 = F.G;
    for (int ph = args.ph_lo; ph < args.ph_hi; ++ph) {
        { int wv_ = wave0, vc_ = vcu0, g_ = G0; asm volatile("" : "+s"(wv_), "+s"(vc_), "+s"(g_)); F.wave = wv_; F.vcu = vc_; F.G = g_;
          int l_ = (int)__builtin_amdgcn_mbcnt_hi(~0u, __builtin_amdgcn_mbcnt_lo(~0u, 0u)); asm volatile("" : "+v"(l_)); F.lane = l_; F.tid = F.wave * 64 + l_;
          unsigned char* w_ = args.ws; asm volatile("" : "+s"(w_)); ws = w_; F.ws = w_;
          KargPtr k_ = (KargPtr)__builtin_amdgcn_kernarg_segment_ptr(); asm volatile("" : "+s"(k_)); F.in.kp = k_; }
        if (ph == PH_FINAL) { final_phase(F); break; }
        const int l = ph / PH_PER_LAYER, pt = ph - l * PH_PER_LAYER;
        if (pt == 0) prep_phase(F, l);
        else if (pt == 3) carry_phase(F);
        else {
            GDesc d; d.ws = ws; d.mode = 0; d.nM = M / BM; d.nN = 1; d.rs_in = nullptr; d.rs_out = nullptr; d.bias = nullptr; d.xold = nullptr; d.xnew = nullptr; d.xb = nullptr;
            int cblk = (int)blockIdx.x; asm volatile("" : "+s"(cblk));
            float* rowss = (float*)(ws + WS_ROWSS);
            switch (pt) {
            case 1: d.A = (const char*)(ws + WS_XB); d.B = (const char*)(ws + WS_WMIX); d.lda = DM; d.ldb = DM; d.K = DM; d.nN = 8; d.rs_in = rowss + (size_t)(2 * l) * M;
                    gemm_phase<GM_MIX>(F.lds, d, F.G, cblk, F.wave); break;
            case 2: d.A = (const char*)(ws + WS_XS); d.B = (const char*)(ws + WS_WS); d.lda = XSK; d.ldb = 256; d.K = 256;
                    gemm_phase<GM_S1>(F.lds, d, F.G, cblk, F.wave); break;
            case 4: d.A = (const char*)(ws + WS_XS); d.B = (const char*)(ws + WS_TW); d.lda = XSK; d.ldb = XSK; d.K = XSK;
                    gemm_phase<GM_S3>(F.lds, d, F.G, cblk, F.wave); break;
            case 5: d.A = (const char*)(ws + WS_YS); d.B = (const char*)(ws + WS_WGLU); d.lda = SW; d.ldb = SW; d.K = SW; d.nN = 2; d.bias = ARG_IN(13) + (size_t)l * SW;
                    gemm_phase<GM_GLU>(F.lds, d, F.G, cblk, F.wave); break;
            case 6: d.A = (const char*)(ws + WS_XB); d.B = (const char*)(ws + WS_WGATE); d.lda = DM; d.ldb = DM; d.K = DM; d.nN = 12; d.rs_in = rowss + (size_t)(2 * l) * M; d.bias = ARG_IN(3) + (size_t)l * 3 * DM;
                    gemm_phase<GM_GATE>(F.lds, d, F.G, cblk, F.wave); break;
            case 7: d.A = (const char*)(ws + WS_BR); d.B = (const char*)(ws + WS_WBR); d.lda = 1536; d.ldb = 1536; d.K = 512; d.nN = 4;
                    gemm_phase<GM_MERGE>(F.lds, d, F.G, cblk, F.wave); break;
            case 8: d.A = (const char*)(ws + WS_MG); d.B = (const char*)(ws + WS_WOUT); d.lda = DM; d.ldb = DM; d.K = DM; d.nN = 4;
                    d.xold = (l == 0) ? ARG_IN(0) : args.out; d.xnew = args.out; d.xb = (bf16*)(ws + WS_XB); d.rs_out = rowss + (size_t)(2 * l + 1) * M;
                    gemm_phase<GM_WOUT>(F.lds, d, F.G, cblk, F.wave); break;
            case 9: d.A = (const char*)(ws + WS_XB); d.B = (const char*)(ws + WS_WGU); d.lda = DM; d.ldb = DM; d.K = DM; d.nN = 22; d.rs_in = rowss + (size_t)(2 * l + 1) * M;
                    gemm_phase<GM_GU>(F.lds, d, F.G, cblk, F.wave); break;
            default: d.A = (const char*)(ws + WS_HID); d.B = (const char*)(ws + WS_WDN); d.lda = FF; d.ldb = FF; d.K = FF; d.nN = 4;
                    d.xold = args.out; d.xnew = args.out; d.xb = (bf16*)(ws + WS_XB); d.rs_out = rowss + (size_t)(2 * l + 2) * M;
                    gemm_phase<GM_WOUT>(F.lds, d, F.G, cblk, F.wave); break;
            }
            if (pt == 2) { __syncthreads(); for (int tile = F.vcu; tile < M / 64; tile += F.G) mixer_tile(F, l, tile); }
        }
        if (ph + 1 < args.ph_hi) xcd_barrier(bar);
    }
}

extern "C" void kernel_launch(void* const* d_in, const int* in_sizes, int n_in, void* d_out, int out_size, void* d_ws, size_t ws_size, hipStream_t stream) {
    static int grid = 0;
    if (grid == 0) {
        if (n_in != 29 || out_size != M * DM || ws_size < WS_END) { fprintf(stderr, "kernel_launch: unexpected shapes (n_in %d out %d ws %zu)\n", n_in, out_size, ws_size); grid = -1; return; }
        int dev = 0, cus = 0, per_cu = 0;
        if (hipGetDevice(&dev) != hipSuccess || hipDeviceGetAttribute(&cus, hipDeviceAttributeMultiprocessorCount, dev) != hipSuccess) { grid = -1; return; }
        if (hipFuncSetAttribute((const void*)mk_fwd, hipFuncAttributeMaxDynamicSharedMemorySize, LDS_BYTES) != hipSuccess) { fprintf(stderr, "kernel_launch: hipFuncSetAttribute failed\n"); grid = -1; return; }
        if (hipOccupancyMaxActiveBlocksPerMultiprocessor(&per_cu, (const void*)mk_fwd, NTHR, LDS_BYTES) != hipSuccess || per_cu < 1) { fprintf(stderr, "kernel_launch: occupancy query says %d blocks per CU\n", per_cu); grid = -1; return; }
        grid = cus;
    }
    if (grid < 0) return;
    (void)hipMemsetAsync((char*)d_ws + WS_CTL, 0, CTL_ZERO_BYTES, stream);
    Args a{};
    for (int i = 0; i < 29; ++i) a.in[i] = (const float*)d_in[i];
    a.out = (float*)d_out; a.ws = (unsigned char*)d_ws;
#if MK_PER_PHASE
    for (int ph = 0; ph < PH_TOTAL; ++ph) { a.ph_lo = ph; a.ph_hi = ph + 1; hipLaunchKernelGGL(mk_fwd, dim3(grid), dim3(NTHR), LDS_BYTES, stream, a); }
#else
    a.ph_lo = 0; a.ph_hi = PH_TOTAL; hipLaunchKernelGGL(mk_fwd, dim3(grid), dim3(NTHR), LDS_BYTES, stream, a);
#endif
}
```

```cpp
#include <hip/hip_runtime.h>
#include <cstdio>
#include <cstdint>

#define LAS __attribute__((address_space(3)))
#define GAS __attribute__((address_space(1)))
template <class T> __device__ __forceinline__ T* as_global(T* p) { return (T*)(GAS T*)p; }
typedef unsigned short bf16;
typedef short bf16x8 __attribute__((ext_vector_type(8)));
typedef float f32x4 __attribute__((ext_vector_type(4)));
typedef float f32x2 __attribute__((ext_vector_type(2)));
typedef unsigned u32x4 __attribute__((ext_vector_type(4)));
typedef unsigned u32x2 __attribute__((ext_vector_type(2)));

#ifndef MK_PROBE
#define MK_PROBE 0
#endif
#ifndef PROBE_A
#define PROBE_A 0
#define PROBE_B 1
#endif
#ifndef PROBE_BLK
#define PROBE_BLK 0
#endif
#if MK_PROBE
#define PSTAMP(k) do { if (blockIdx.x == PROBE_BLK && threadIdx.x == 0) ((volatile LAS unsigned long long*)(F.lds + 132096))[k] = __builtin_amdgcn_s_memrealtime(); } while (0)
#else
#define PSTAMP(k) do {} while (0)
#endif
#ifndef MK_DIAG
#define MK_DIAG 0
#define DIAG_WHAT 0
#define DIAG_AFTER 20
#define DIAG_OFF 0
#define DIAG_LEN 0
#endif
#ifndef MK_SP2
#define MK_SP2 1
#endif
#ifndef MK_PER_PHASE
#define MK_PER_PHASE 0
#endif

constexpr int DM = 1024, BATCH = 8, SEQ = 2048, DEPTH = 2, M = BATCH * SEQ;
constexpr int SW = 512, NG = 32, NP = 16, NS = 64, CW = 512, CKW = 31, PW = 512, PGW = 128, INW = 5120, FF = 2816;
constexpr int CL = 16, NCHUNK = M / CL, CPB = SEQ / CL, XSK = 384;
constexpr float EPS = 1e-6f;
constexpr int NWAVES = 8, NTHR = 512;

constexpr size_t MiB = 1u << 20;
constexpr size_t WS_CTL = 0, CTL_ZERO_BYTES = 64 * 1024;
constexpr size_t WS_LAM16_0 = 1 * MiB;
constexpr size_t WS_CWT_0 = 1 * MiB + 64 * 1024;
constexpr size_t WS_E0 = 2 * MiB, WS_E1 = 220 * MiB;
constexpr size_t EO_WMIX = 0, EO_WS = 4 * MiB, EO_TW = 8 * MiB, EO_WGLU = 14 * MiB, E_BYTES = 14 * MiB + MiB / 2;
__host__ __device__ __forceinline__ constexpr size_t ws_e(int e) { return e ? WS_E1 : WS_E0; }
__host__ __device__ __forceinline__ constexpr size_t ws_lam(int e) { return WS_LAM16_0 + (size_t)e * 16384; }
__host__ __device__ __forceinline__ constexpr size_t ws_cwt(int e) { return WS_CWT_0 + (size_t)e * 65536; }
constexpr size_t WS_WGATE = WS_E0 + E_BYTES;
constexpr size_t WS_WBR = WS_WGATE + 6 * MiB;
constexpr size_t WS_WOUT = WS_WBR + 3 * MiB;
constexpr size_t WS_WGU = WS_WOUT + 2 * MiB;
constexpr size_t WS_WDN = WS_WGU + 11 * MiB;
constexpr size_t WS_XB = 44 * MiB;
constexpr size_t WS_RC = 76 * MiB;
constexpr size_t WS_G = WS_RC, WS_HID = WS_RC;
constexpr size_t WS_XS = WS_RC;
constexpr size_t WS_HC = WS_XS + 24 * MiB;
constexpr size_t WS_V = WS_HC + 16 * MiB;
constexpr size_t WS_YS = WS_V + 32 * MiB;
constexpr size_t WS_BR = 172 * MiB;
constexpr size_t WS_XB2 = WS_BR;
constexpr size_t WS_RSA = 252 * MiB, WS_RSB = 253 * MiB;
constexpr size_t WS_END = 254 * MiB;
static_assert(WS_WDN + 5 * MiB + MiB / 2 <= WS_XB && WS_YS + 16 * MiB <= WS_RC + 96 * MiB && WS_E1 + E_BYTES <= WS_RSA && ws_cwt(1) + 65536 <= WS_E0, "ws map");

constexpr int CW_BAR = 4096;

constexpr int RST_OFF = 133120;
constexpr int RING_BYTES = 131072, LDSCTL_OFF = RING_BYTES, MISC_OFF = LDSCTL_OFF + 320, LDS_BYTES = 147456;

#define RLX_AGENT __ATOMIC_RELAXED, __HIP_MEMORY_SCOPE_AGENT
#define LDS_WAIT() asm volatile("s_waitcnt lgkmcnt(0)" ::: "memory")
#define VM_WAIT() asm volatile("s_waitcnt vmcnt(0)" ::: "memory")

__device__ __forceinline__ unsigned f2bf(float f) { unsigned u = __builtin_bit_cast(unsigned, f); return (u + 0x7fffu + ((u >> 16) & 1u)) >> 16; }
__device__ __forceinline__ unsigned pk2(float lo, float hi) { return f2bf(lo) | (f2bf(hi) << 16); }
typedef __bf16 bf16x2_t __attribute__((ext_vector_type(2)));
__device__ __forceinline__ unsigned cvt_pk_bf16(float lo, float hi) { const bf16x2_t v = __builtin_convertvector((f32x2){lo, hi}, bf16x2_t); return __builtin_bit_cast(unsigned, v); }
__device__ __forceinline__ float bf_lo(unsigned w) { return __builtin_bit_cast(float, w << 16); }
__device__ __forceinline__ float bf_hi(unsigned w) { return __builtin_bit_cast(float, w & 0xffff0000u); }
__device__ __forceinline__ float fsigmoid(float v) { return __builtin_amdgcn_rcpf(1.0f + __builtin_amdgcn_exp2f(-1.4426950408889634f * v)); }
__device__ __forceinline__ float fgelu(float v) { return v * fsigmoid(1.5957691216057308f * (v + 0.044715f * v * v * v)); }

#define XB_TMO      128
#define XB_XCNT(j)  (256  + 64 * (j))
#define XB_XSUB(j)  (1280 + 64 * (j))
#define XB_XGEN(j)  (2304 + 64 * (j))
#define XB_TOP      3328
#define XB_TOPGEN   3392
#define XCD_BAR_WORDS 3456
#define XB_SPIN_CAP (1u << 18)
__device__ __forceinline__ unsigned xb_ld(unsigned* p)              { return __hip_atomic_load(p, __ATOMIC_RELAXED, __HIP_MEMORY_SCOPE_AGENT); }
__device__ __forceinline__ unsigned xb_add(unsigned* p, unsigned v) { return __hip_atomic_fetch_add(p, v, __ATOMIC_RELAXED, __HIP_MEMORY_SCOPE_AGENT); }
__device__ __forceinline__ unsigned xb_xcc_id() { return (unsigned)__builtin_amdgcn_s_getreg((3 << 11) | 20) & 0xFu; }
#define XB_SPIN(cond, bar) do { unsigned _sp = 0; while (cond) { __builtin_amdgcn_s_sleep(1); \
    if ((++_sp & 255u) == 0u) { if (xb_ld(&(bar)[XB_TMO])) break; if (_sp > XB_SPIN_CAP) { atomicAdd(&(bar)[XB_TMO], 1u); break; } } } } while (0)
struct XcdBarrier { unsigned* bar; unsigned x; volatile LAS unsigned* st; };
__device__ __forceinline__ XcdBarrier xcd_barrier_post(unsigned* bar, volatile LAS unsigned* st) {
    XcdBarrier b; b.bar = bar; b.x = xb_xcc_id(); b.st = st;
    if (threadIdx.x == 0) (void)xb_add(&bar[XB_XCNT(b.x)], 1u);
    return b;
}
__device__ __forceinline__ void xcd_barrier_complete(unsigned* bar, unsigned x, unsigned& nloc, unsigned& nx) {
    const unsigned G = gridDim.x * gridDim.y * gridDim.z;
    unsigned sum, cnt, mine, sp = 0u;
    for (;;) {
        sum = 0u; cnt = 0u; mine = 0u;
#pragma unroll
        for (unsigned j = 0; j < 16; ++j) { const unsigned c = xb_ld(&bar[XB_XCNT(j)]); sum += c; cnt += (c > 0u) ? 1u : 0u; mine = (j == x) ? c : mine; }
        if (sum == G) break;
        __builtin_amdgcn_s_sleep(1);
        if ((++sp & 255u) == 0u) { if (xb_ld(&bar[XB_TMO])) break; if (sp > XB_SPIN_CAP) { atomicAdd(&bar[XB_TMO], 1u); break; } }
    }
    nloc = mine > 0u ? mine : 1u; nx = cnt > 0u ? cnt : 1u;
}
__device__ __forceinline__ void xcd_barrier(const XcdBarrier& b) {
    asm volatile("s_waitcnt vmcnt(0)" ::: "memory");
    __syncthreads();
    if (threadIdx.x == 0) {
        unsigned* bar = b.bar;
        __builtin_amdgcn_s_waitcnt(0);
        unsigned nloc = b.st[0], nx = b.st[1];
        if (nloc == 0u) { xcd_barrier_complete(bar, b.x, nloc, nx); b.st[0] = nloc; b.st[1] = nx; }
        const unsigned old = xb_add(&bar[XB_XSUB(b.x)], 1u);
        const unsigned gen = old / nloc;
        if (old + 1u == (gen + 1u) * nloc) {
            __builtin_amdgcn_fence(__ATOMIC_RELEASE, "agent");
            asm volatile("s_waitcnt vmcnt(0)" ::: "memory");
            const unsigned og = xb_add(&bar[XB_TOP], 1u);
            const unsigned tg = og / nx;
            if (og + 1u == (tg + 1u) * nx) xb_add(&bar[XB_TOPGEN], 1u);
            else XB_SPIN(xb_ld(&bar[XB_TOPGEN]) == tg, bar);
            __builtin_amdgcn_fence(__ATOMIC_ACQUIRE, "agent");
            xb_add(&bar[XB_XGEN(b.x)], 1u);
            asm volatile("s_waitcnt vmcnt(0)" ::: "memory");
        } else {
            XB_SPIN(xb_ld(&bar[XB_XGEN(b.x)]) == gen, bar);
            __builtin_amdgcn_fence(__ATOMIC_ACQUIRE, "agent");
            asm volatile("s_waitcnt vmcnt(0)" ::: "memory");
        }
    }
    __syncthreads();
}

struct Args { const float* in[29]; float* out; unsigned char* ws; int ph_lo, ph_hi; };

enum GemmMode { GM_MIX = 0, GM_S1, GM_S3, GM_GLU, GM_GATE, GM_MERGE, GM_WOUT, GM_GU, GM_DOWN };
struct GDesc {
    int mode; const char* A; const char* B; int lda, ldb, K, nM, nN;
    const float* rs_in;
    float* rs_out;
    const float* bias;
    const float* xold; float* xnew; bf16* xb; const bf16* xres;
    unsigned char* ws;
    LAS unsigned char* lds; int rs_pm;
    int eb;
    int blk;
};
struct Unit { const char* A; const char* B; int pm, pn, aux; };

constexpr int BM = 256, BK = 64, HALF = 128, HTB = HALF * BK * 2, NXCD = 8, WGM = 8;
__device__ __forceinline__ int lds_byte(int r, int c) { const int st = (r >> 4) * 2 + (c >> 5), rr = r & 15, cc = c & 31, ob = rr * 64 + cc * 2; return st * 1024 + (ob ^ (((ob >> 9) & 1) << 5)); }
__device__ __forceinline__ void stage_rc(int b, int& R, int& C) { const int st = b / 1024, sb = b % 1024, swz = sb ^ (((sb >> 9) & 1) << 5); R = (st >> 1) * 16 + swz / 64; C = (st & 1) * 32 + (swz % 64) / 2; }
__device__ __forceinline__ int perm32(int rho) { const int n = rho >> 4, i = rho & 15; return 8 * (i >> 2) + 4 * n + (i & 3); }

template <int MODE> __device__ __forceinline__ bool sched_next(const GDesc& d, int G, int c, int i, Unit& u) {
    if (MODE == GM_S1 || MODE == GM_S3) {
        const int L = i * G + c; if (L >= 128) return false;
        const int g = L >> 2, r = L & 3;
        u.A = d.A + (size_t)(g * NCHUNK + r * 256) * d.lda * 2; u.B = d.B + (size_t)g * 256 * d.ldb * 2; u.pm = r; u.pn = 0; u.aux = g; return true;
    }
    int ii = i, sub = 0; if (MODE == GM_MERGE) { ii = i / 3; sub = i - 3 * ii; }
    const int nwg = d.nM * d.nN; const long L = (long)ii * G + c; if (L >= nwg) return false;
    int wgid = (int)L; { const int q = nwg / NXCD, r = nwg % NXCD, xcd = wgid % NXCD, off = wgid / NXCD; wgid = (xcd < r ? xcd * (q + 1) : r * (q + 1) + (xcd - r) * q) + off; }
    const int nig = WGM * d.nN, gid = wgid / nig, fm = gid * WGM, gsz = (d.nM - fm) < WGM ? (d.nM - fm) : WGM;
    u.pm = fm + ((wgid % nig) % gsz); u.pn = (wgid % nig) / gsz; u.aux = sub;
    u.A = d.A + (size_t)u.pm * 256 * d.lda * 2 + sub * 1024; u.B = d.B + (size_t)u.pn * 256 * d.ldb * 2 + sub * 1024; return true;
}

__device__ __forceinline__ void store8(bf16* p, const f32x4& v0, const f32x4& v1) {
    u32x4 w; w.x = cvt_pk_bf16(v0[0], v0[1]); w.y = cvt_pk_bf16(v0[2], v0[3]); w.z = cvt_pk_bf16(v1[0], v1[1]); w.w = cvt_pk_bf16(v1[2], v1[3]); *(GAS u32x4*)p = w;
}
__device__ __forceinline__ void load8(const bf16* p, f32x4& v0, f32x4& v1) {
    const u32x4 w = *(const GAS u32x4*)p; v0 = (f32x4){bf_lo(w.x), bf_hi(w.x), bf_lo(w.y), bf_hi(w.y)}; v1 = (f32x4){bf_lo(w.z), bf_hi(w.z), bf_lo(w.w), bf_hi(w.w)};
}
__device__ __forceinline__ float row_rs(const GAS float* slots, int row) {
    const GAS float* q = (const GAS float*)slots + (size_t)row * 4; const f32x4 v = (*(const GAS f32x4*)q + *(const GAS f32x4*)(q + 4 * M)) + (*(const GAS f32x4*)(q + 8 * M) + *(const GAS f32x4*)(q + 12 * M));
    return __builtin_amdgcn_rsqf(((v[0] + v[1]) + (v[2] + v[3])) * (1.0f / DM) + EPS);
}
__device__ __forceinline__ f32x4 sig4(const f32x4& v) { return (f32x4){fsigmoid(v[0]), fsigmoid(v[1]), fsigmoid(v[2]), fsigmoid(v[3])}; }
__device__ __forceinline__ f32x4 rcp4(const f32x4& v) { return (f32x4){__builtin_amdgcn_rcpf(v[0]), __builtin_amdgcn_rcpf(v[1]), __builtin_amdgcn_rcpf(v[2]), __builtin_amdgcn_rcpf(v[3])}; }
__device__ __forceinline__ f32x4 gelu4(const f32x4& v) { return (f32x4){fgelu(v[0]), fgelu(v[1]), fgelu(v[2]), fgelu(v[3])}; }

template <int MODE> __device__ __forceinline__ bool epilogue(const GDesc& d, const Unit& u, f32x4 (&acc)[2][2][4][2], int wr, int wc, int fr, int fq) {
    asm volatile("" : "+v"(fr), "+v"(fq));
    constexpr int mode = MODE;
    unsigned char* ws = d.ws;
    const int rl0 = wr * 64 + fr;
    const int cl0 = wc * 32 + 8 * fq;
    if constexpr (mode == GM_MIX) {
        const int rowb = u.pm * BM + rl0;
        if (u.pn < 2) {
            bf16* XS = (bf16*)(ws + WS_XS);
#pragma unroll
            for (int ai = 0; ai < 2; ++ai)
#pragma unroll
                for (int m = 0; m < 4; ++m) { const int row = rowb + ai * HALF + m * 16; const float rs = (u.pm == d.rs_pm) ? *(const LAS float*)(d.lds + RST_OFF + (rl0 + ai * HALF + m * 16) * 4) : row_rs((const GAS float*)d.rs_in, row);
#pragma unroll
                    for (int bj = 0; bj < 2; ++bj) { const int ch = u.pn * BM + bj * HALF + cl0; const int g = ch >> 4, p0 = ch & 15;
                        store8(XS + ((size_t)(g * NCHUNK + (row >> 4)) * XSK + (row & 15) * 16 + p0), acc[ai][bj][m][0] * rs, acc[ai][bj][m][1] * rs); } }
        } else if (u.pn < 6) {
            bf16* HC = (bf16*)(ws + WS_HC);
#pragma unroll
            for (int ai = 0; ai < 2; ++ai)
#pragma unroll
                for (int m = 0; m < 4; ++m) { const int row = rowb + ai * HALF + m * 16; const float rs = (u.pm == d.rs_pm) ? *(const LAS float*)(d.lds + RST_OFF + (rl0 + ai * HALF + m * 16) * 4) : row_rs((const GAS float*)d.rs_in, row);
                    store8(HC + (size_t)row * CW + (u.pn - 2) * HALF + cl0, acc[ai][0][m][0] * rs * sig4(acc[ai][1][m][0] * rs), acc[ai][0][m][1] * rs * sig4(acc[ai][1][m][1] * rs)); }
        } else {
            bf16* V = (bf16*)(ws + WS_V);
#pragma unroll
            for (int ai = 0; ai < 2; ++ai)
#pragma unroll
                for (int m = 0; m < 4; ++m) { const int row = rowb + ai * HALF + m * 16; const float rs = (u.pm == d.rs_pm) ? *(const LAS float*)(d.lds + RST_OFF + (rl0 + ai * HALF + m * 16) * 4) : row_rs((const GAS float*)d.rs_in, row);
#pragma unroll
                    for (int bj = 0; bj < 2; ++bj) store8(V + (size_t)row * PW + (u.pn - 6) * BM + bj * HALF + cl0, acc[ai][bj][m][0] * rs, acc[ai][bj][m][1] * rs); }
        }
        return false;
    }
    if constexpr (mode == GM_GATE) {
        GAS bf16* gp = (GAS bf16*)(ws + WS_G) + (size_t)d.blk * (3 * 65536) + (size_t)(u.pn >> 2) * 65536 + ((wr * 4 + wc) * 64 + fq * 16 + fr) * 8;
        const int rowb = u.pm * BM + rl0, colb = u.pn * BM + cl0;
        f32x4 bv[2][2];
#pragma unroll
        for (int bj = 0; bj < 2; ++bj)
#pragma unroll
            for (int n = 0; n < 2; ++n) bv[bj][n] = *(const GAS f32x4*)(d.bias + colb + bj * HALF + 4 * n);
#pragma unroll
        for (int ai = 0; ai < 2; ++ai)
#pragma unroll
            for (int m = 0; m < 4; ++m) { const int row = rowb + ai * HALF + m * 16; const float rs = (u.pm == d.rs_pm) ? *(const LAS float*)(d.lds + RST_OFF + (rl0 + ai * HALF + m * 16) * 4) : row_rs((const GAS float*)d.rs_in, row);
#pragma unroll
                for (int bj = 0; bj < 2; ++bj) store8((bf16*)(gp + ((ai * 4 + m) * 2 + bj) * 4096), sig4(acc[ai][bj][m][0] * rs + bv[bj][0]), sig4(acc[ai][bj][m][1] * rs + bv[bj][1])); }
        return false;
    }
    if constexpr (mode == GM_S3) {
        bf16* YS = (bf16*)(ws + WS_YS);
#pragma unroll
        for (int ai = 0; ai < 2; ++ai)
#pragma unroll
            for (int m = 0; m < 4; ++m) { const int chunk = u.pm * BM + rl0 + ai * HALF + m * 16;
#pragma unroll
                for (int bj = 0; bj < 2; ++bj) { const int col = bj * HALF + cl0; const int tok = chunk * CL + (col >> 4);
                    store8(YS + (size_t)tok * SW + u.aux * NP + (col & 15), gelu4(acc[ai][bj][m][0]), gelu4(acc[ai][bj][m][1])); } }
        return false;
    }
    if constexpr (mode == GM_GLU) {
        const bf16* YS = (const bf16*)(ws + WS_YS); bf16* BR = (bf16*)(ws + WS_BR); const int rowb = u.pm * BM + rl0, colb = u.pn * BM + cl0;
        f32x4 bv[2][2];
#pragma unroll
        for (int bj = 0; bj < 2; ++bj)
#pragma unroll
            for (int n = 0; n < 2; ++n) bv[bj][n] = *(const GAS f32x4*)(d.bias + colb + bj * HALF + 4 * n);
#pragma unroll
        for (int ai = 0; ai < 2; ++ai) {
            u32x4 yw[4][2];
#pragma unroll
            for (int m = 0; m < 4; ++m)
#pragma unroll
                for (int bj = 0; bj < 2; ++bj) yw[m][bj] = *(const GAS u32x4*)(YS + (size_t)(rowb + ai * HALF + m * 16) * SW + colb + bj * HALF);
#pragma unroll
            for (int m = 0; m < 4; ++m) { const int row = rowb + ai * HALF + m * 16;
#pragma unroll
                for (int bj = 0; bj < 2; ++bj) { const u32x4 w = yw[m][bj];
                    const f32x4 y0 = (f32x4){bf_lo(w.x), bf_hi(w.x), bf_lo(w.y), bf_hi(w.y)}, y1 = (f32x4){bf_lo(w.z), bf_hi(w.z), bf_lo(w.w), bf_hi(w.w)};
                    store8(BR + (size_t)row * 1536 + colb + bj * HALF, y0 * sig4(acc[ai][bj][m][0] + bv[bj][0]), y1 * sig4(acc[ai][bj][m][1] + bv[bj][1])); } }
        }
        return false;
    }
    if constexpr (mode == GM_MERGE) {
        const GAS bf16* gp = (const GAS bf16*)(ws + WS_G) + (size_t)d.blk * (3 * 65536) + ((wr * 4 + wc) * 64 + fq * 16 + fr) * 8;
        bf16* MG = d.xb; const int rowb = u.pm * BM + rl0, colb = u.pn * BM + cl0, sub = u.aux;
#pragma unroll
        for (int ai = 0; ai < 2; ++ai)
#pragma unroll
        for (int mh = 0; mh < 2; ++mh) {
            u32x4 ga[2][2], gb[2][2];
#pragma unroll
            for (int m2 = 0; m2 < 2; ++m2)
#pragma unroll
                for (int bj = 0; bj < 2; ++bj) { const GAS bf16* p = gp + (size_t)sub * 65536 + ((ai * 4 + mh * 2 + m2) * 2 + bj) * 4096;
                    ga[m2][bj] = *(const GAS u32x4*)p; gb[m2][bj] = (sub < 2) ? *(const GAS u32x4*)(p + 65536) : ga[m2][bj]; }
#pragma unroll
            for (int m2 = 0; m2 < 2; ++m2) { const int m = mh * 2 + m2, row = rowb + ai * HALF + m * 16;
#pragma unroll
                for (int bj = 0; bj < 2; ++bj) { const u32x4 wa = ga[m2][bj], wb = gb[m2][bj];
                    const f32x4 a0 = (f32x4){bf_lo(wa.x), bf_hi(wa.x), bf_lo(wa.y), bf_hi(wa.y)}, a1 = (f32x4){bf_lo(wa.z), bf_hi(wa.z), bf_lo(wa.w), bf_hi(wa.w)};
                    if (sub < 2) { const f32x4 b0 = (f32x4){bf_lo(wb.x), bf_hi(wb.x), bf_lo(wb.y), bf_hi(wb.y)}, b1 = (f32x4){bf_lo(wb.z), bf_hi(wb.z), bf_lo(wb.w), bf_hi(wb.w)};
                        acc[ai][bj][m][0] *= a0 * rcp4(b0); acc[ai][bj][m][1] *= a1 * rcp4(b1); }
                    else store8(MG + (size_t)row * DM + colb + bj * HALF, acc[ai][bj][m][0] * a0, acc[ai][bj][m][1] * a1); } }
        }
        return sub < 2;
    }
    if constexpr (mode == GM_WOUT || mode == GM_DOWN) {
        const int rowb = u.pm * BM + rl0, colb = u.pn * BM + cl0; const bool res16 = (d.xold == nullptr), st32 = (d.xnew != nullptr);
#pragma unroll
        for (int ai = 0; ai < 2; ++ai)
#pragma unroll
        for (int mh = 0; mh < 2; ++mh) {
            f32x4 xo[2][2][2];
#pragma unroll
            for (int m2 = 0; m2 < 2; ++m2)
#pragma unroll
                for (int bj = 0; bj < 2; ++bj) { const size_t o = (size_t)(rowb + ai * HALF + (mh * 2 + m2) * 16) * DM + colb + bj * HALF;
                    if (res16) load8(d.xres + o, xo[m2][bj][0], xo[m2][bj][1]);
                    else { const GAS float* p = (const GAS float*)d.xold + o; xo[m2][bj][0] = *(const GAS f32x4*)p; xo[m2][bj][1] = *(const GAS f32x4*)(p + 4); } }
#pragma unroll
            for (int m2 = 0; m2 < 2; ++m2) { const int m = mh * 2 + m2; const int row = rowb + ai * HALF + m * 16; float ss = 0.f;
#pragma unroll
                for (int bj = 0; bj < 2; ++bj) { const size_t o = (size_t)row * DM + colb + bj * HALF;
                    const f32x4 x0 = xo[m2][bj][0] + acc[ai][bj][m][0], x1 = xo[m2][bj][1] + acc[ai][bj][m][1];
                    if (st32) { *(GAS f32x4*)(d.xnew + o) = x0; *(GAS f32x4*)(d.xnew + o + 4) = x1; }
                    store8(d.xb + o, x0, x1);
                    ss += (x0[0] * x0[0] + x0[1] * x0[1]) + (x0[2] * x0[2] + x0[3] * x0[3]) + (x1[0] * x1[0] + x1[1] * x1[1]) + (x1[2] * x1[2] + x1[3] * x1[3]); }
                ss += __shfl_xor(ss, 16); ss += __shfl_xor(ss, 32);
                if (fq == 0) *((GAS float*)d.rs_out + (size_t)u.pn * (4 * M) + (size_t)row * 4 + wc) = ss; }
        }
        return false;
    }
    if constexpr (mode == GM_GU) {
        bf16* HID = (bf16*)(ws + WS_HID); const int rowb = u.pm * BM + rl0;
#pragma unroll
        for (int ai = 0; ai < 2; ++ai)
#pragma unroll
            for (int m = 0; m < 4; ++m) { const int row = rowb + ai * HALF + m * 16; const float rs = (u.pm == d.rs_pm) ? *(const LAS float*)(d.lds + RST_OFF + (rl0 + ai * HALF + m * 16) * 4) : row_rs((const GAS float*)d.rs_in, row);
                const f32x4 g0 = acc[ai][0][m][0] * rs, g1 = acc[ai][0][m][1] * rs;
                store8(HID + (size_t)row * FF + u.pn * HALF + cl0, g0 * sig4(g0) * (acc[ai][1][m][0] * rs), g1 * sig4(g1) * (acc[ai][1][m][1] * rs)); }
        return false;
    }
}

template <int MODE> __device__ __forceinline__ void gemm_phase(LAS unsigned char* lds, const GDesc& g, int G, int c, int wave_id) {
    int lane = (int)__builtin_amdgcn_mbcnt_hi(~0u, __builtin_amdgcn_mbcnt_lo(~0u, 0u)); asm volatile("" : "+v"(lane));
    const int wid = wave_id, tid = wid * 64 + lane, wr = wid >> 2, wc = wid & 3, fr = lane & 15, fq = lane >> 4;
    const int K = g.K, nt = K / BK;
    unsigned voffA[2], voffB[2];
#pragma unroll
    for (int i = 0; i < 2; ++i) { int R, C; stage_rc(tid * 16 + i * 8192, R, C); const int Rb = (R & ~31) + perm32(R & 31);
        voffA[i] = (unsigned)(R * g.lda + C) * 2u; voffB[i] = (unsigned)(Rb * g.ldb + C) * 2u; }
    const size_t kstep = (size_t)(BK * 2);
    const size_t hstepA = (size_t)HALF * g.lda * 2, hstepB = (size_t)HALF * g.ldb * 2;
    const unsigned ldsw = (unsigned)wid * 1024u;
    const int aoff = lds_byte(wr * 64 + fr, fq * 8), boff = lds_byte(wc * 32 + fr, fq * 8);
#define PG8_SA(b, h) (((b) * 2 + (h)) * HTB)
#define PG8_SB(b, h) ((4 + (b) * 2 + (h)) * HTB)
#define PG8_STAGE(bufoff, gbase, voff) do { _Pragma("unroll") for (int _i = 0; _i < 2; ++_i) \
        __builtin_amdgcn_global_load_lds((const unsigned*)((const char*)(gbase) + (voff)[_i]), (LAS unsigned*)(lds + (bufoff) + ldsw + _i * 8192), 16, 0, 0); } while (0)
#define PG8_LDA(dst, b, h) do { _Pragma("unroll") for (int m = 0; m < 4; ++m) _Pragma("unroll") for (int k = 0; k < 2; ++k) dst[m][k] = *(const LAS bf16x8*)(lds + PG8_SA(b, h) + aoff + m * 2048 + k * 1024); } while (0)
#define PG8_LDB(dst, b, h) do { _Pragma("unroll") for (int n = 0; n < 2; ++n) _Pragma("unroll") for (int k = 0; k < 2; ++k) dst[n][k] = *(const LAS bf16x8*)(lds + PG8_SB(b, h) + boff + n * 2048 + k * 1024); } while (0)
#define PG8_MMA(ai, bj, At, Bt) do { __builtin_amdgcn_s_setprio(1); _Pragma("unroll") for (int m = 0; m < 4; ++m) _Pragma("unroll") for (int n = 0; n < 2; ++n) _Pragma("unroll") for (int k = 0; k < 2; ++k) \
        acc[ai][bj][m][n] = __builtin_amdgcn_mfma_f32_16x16x32_bf16(Bt[n][k], At[m][k], acc[ai][bj][m][n], 0, 0, 0); __builtin_amdgcn_s_setprio(0); } while (0)
#define PG8_WAIT_V(n) asm volatile("s_waitcnt vmcnt(" #n ")" ::: "memory")
#define PG8_WAIT_L(n) asm volatile("s_waitcnt lgkmcnt(" #n ")" ::: "memory")
#define PG8_BAR __builtin_amdgcn_s_barrier()
#define PG8_SCHED __builtin_amdgcn_sched_barrier(0)
    Unit cur, nxt; int ui = 0;
    if (!sched_next<MODE>(g, G, c, 0, cur)) return;
    GDesc gd = g; gd.lds = lds; gd.rs_pm = -1;
    if constexpr (MODE == GM_MIX || MODE == GM_GATE || MODE == GM_GU) {
        if (tid < 256) *(LAS float*)(lds + RST_OFF + tid * 4) = row_rs((const GAS float*)g.rs_in, cur.pm * BM + tid);
        gd.rs_pm = cur.pm;
        asm volatile("s_waitcnt vmcnt(0) lgkmcnt(0)" ::: "memory"); __builtin_amdgcn_s_barrier(); asm volatile("" ::: "memory");
    }
    f32x4 acc[2][2][4][2];
#pragma unroll
    for (int a = 0; a < 2; ++a)
#pragma unroll
        for (int b = 0; b < 2; ++b)
#pragma unroll
            for (int m = 0; m < 4; ++m)
#pragma unroll
                for (int n = 0; n < 2; ++n) acc[a][b][m][n] = (f32x4){0.f, 0.f, 0.f, 0.f};
    bf16x8 At[4][2], B0[2][2], B1[2][2];
    const char* cA = cur.A; const char* cB = cur.B;
#if MK_SP2
    PG8_STAGE(PG8_SB(0, 0), cB, voffB); PG8_STAGE(PG8_SB(0, 1), cB + hstepB, voffB); PG8_STAGE(PG8_SA(0, 0), cA, voffA); PG8_STAGE(PG8_SA(0, 1), cA + hstepA, voffA);
    if (wr == 1) PG8_BAR;
    PG8_WAIT_V(2); PG8_BAR;
    PG8_STAGE(PG8_SB(1, 0), cB + kstep, voffB); PG8_STAGE(PG8_SA(1, 0), cA + kstep, voffA); PG8_STAGE(PG8_SB(1, 1), cB + hstepB + kstep, voffB);
    PG8_WAIT_V(6); PG8_BAR;
#else
    PG8_STAGE(PG8_SB(0, 0), cB, voffB); PG8_STAGE(PG8_SA(0, 0), cA, voffA); PG8_STAGE(PG8_SB(0, 1), cB + hstepB, voffB); PG8_STAGE(PG8_SA(0, 1), cA + hstepA, voffA);
    if (wr == 1) PG8_BAR;
    PG8_WAIT_V(4); PG8_BAR;
    PG8_STAGE(PG8_SB(1, 0), cB + kstep, voffB); PG8_STAGE(PG8_SA(1, 0), cA + kstep, voffA); PG8_STAGE(PG8_SB(1, 1), cB + hstepB + kstep, voffB);
    PG8_WAIT_V(6); PG8_BAR;
#endif
    for (;;) {
        const bool has_next = sched_next<MODE>(g, G, c, ui + 1, nxt);
        const char* nA = has_next ? nxt.A : cA; const char* nB = has_next ? nxt.B : cB;
        for (int t = 0; t < nt; t += 2) {
            const bool last = (t == nt - 2);
            const char* a1 = cA + (size_t)(t + 1) * kstep;
            const char* a2 = last ? nA : cA + (size_t)(t + 2) * kstep; const char* b2 = last ? nB : cB + (size_t)(t + 2) * kstep;
            const char* a3 = a2 + kstep; const char* b3 = b2 + kstep;
#if MK_SP2
            PG8_LDB(B0, 0, 0); PG8_LDB(B1, 0, 1); PG8_SCHED; PG8_LDA(At, 0, 0); PG8_STAGE(PG8_SA(1, 1), a1 + hstepA, voffA);
            PG8_WAIT_V(8); PG8_WAIT_L(0); PG8_BAR; PG8_MMA(0, 0, At, B0); PG8_MMA(0, 1, At, B1); PG8_BAR; PG8_SCHED;
            PG8_LDA(At, 0, 1); PG8_STAGE(PG8_SB(0, 0), b2, voffB); PG8_STAGE(PG8_SB(0, 1), b2 + hstepB, voffB); PG8_STAGE(PG8_SA(0, 0), a2, voffA);
            PG8_WAIT_V(8); PG8_WAIT_L(0); PG8_BAR; PG8_MMA(1, 0, At, B0); PG8_MMA(1, 1, At, B1); PG8_BAR; PG8_SCHED;
            PG8_LDB(B0, 1, 0); PG8_LDB(B1, 1, 1); PG8_SCHED; PG8_LDA(At, 1, 0); PG8_STAGE(PG8_SA(0, 1), a2 + hstepA, voffA);
            PG8_WAIT_V(8); PG8_WAIT_L(0); PG8_BAR; PG8_MMA(0, 0, At, B0); PG8_MMA(0, 1, At, B1); PG8_BAR; PG8_SCHED;
            PG8_LDA(At, 1, 1); PG8_STAGE(PG8_SB(1, 0), b3, voffB); PG8_STAGE(PG8_SB(1, 1), b3 + hstepB, voffB); PG8_STAGE(PG8_SA(1, 0), a3, voffA);
            PG8_WAIT_V(8); PG8_WAIT_L(0); PG8_BAR; PG8_MMA(1, 0, At, B0); PG8_MMA(1, 1, At, B1); PG8_BAR; PG8_SCHED;
#else
            PG8_LDB(B0, 0, 0); PG8_SCHED; PG8_LDA(At, 0, 0); PG8_STAGE(PG8_SA(1, 1), a1 + hstepA, voffA);
            PG8_WAIT_L(8); PG8_BAR; PG8_WAIT_L(0); PG8_MMA(0, 0, At, B0); PG8_BAR; PG8_SCHED;
            PG8_LDB(B1, 0, 1); PG8_STAGE(PG8_SB(0, 0), b2, voffB);
            PG8_BAR; PG8_WAIT_L(0); PG8_MMA(0, 1, At, B1); PG8_BAR;
            PG8_LDA(At, 0, 1); PG8_STAGE(PG8_SA(0, 0), a2, voffA);
            PG8_BAR; PG8_WAIT_L(0); PG8_MMA(1, 0, At, B0); PG8_BAR; PG8_SCHED;
            PG8_STAGE(PG8_SB(0, 1), b2 + hstepB, voffB);
            PG8_WAIT_V(6); PG8_BAR; PG8_MMA(1, 1, At, B1); PG8_BAR;
            PG8_LDB(B0, 1, 0); PG8_SCHED; PG8_LDA(At, 1, 0); PG8_STAGE(PG8_SA(0, 1), a2 + hstepA, voffA);
            PG8_WAIT_L(8); PG8_BAR; PG8_WAIT_L(0); PG8_MMA(0, 0, At, B0); PG8_BAR; PG8_SCHED;
            PG8_LDB(B1, 1, 1); PG8_STAGE(PG8_SB(1, 0), b3, voffB);
            PG8_BAR; PG8_WAIT_L(0); PG8_MMA(0, 1, At, B1); PG8_BAR;
            PG8_LDA(At, 1, 1); PG8_STAGE(PG8_SA(1, 0), a3, voffA);
            PG8_BAR; PG8_WAIT_L(0); PG8_MMA(1, 0, At, B0); PG8_BAR; PG8_SCHED;
            PG8_STAGE(PG8_SB(1, 1), b3 + hstepB, voffB);
            PG8_WAIT_V(6); PG8_BAR; PG8_MMA(1, 1, At, B1); PG8_BAR;
#endif
        }
        if (wr == 0) PG8_BAR;
        bool keep = false;
        if constexpr (MODE == GM_S1) break;
        else keep = epilogue<MODE>(gd, cur, acc, wr, wc, fr, fq);
        if (!has_next) break;
        if (!keep) {
#pragma unroll
            for (int a = 0; a < 2; ++a)
#pragma unroll
                for (int b = 0; b < 2; ++b)
#pragma unroll
                    for (int m = 0; m < 4; ++m)
#pragma unroll
                        for (int n = 0; n < 2; ++n) acc[a][b][m][n] = (f32x4){0.f, 0.f, 0.f, 0.f};
        }
        cur = nxt; cA = nA; cB = nB; ++ui;
        if (wr == 1) PG8_BAR;
    }
    PG8_WAIT_V(0);
    PG8_BAR; asm volatile("" ::: "memory");
    if constexpr (MODE == GM_S1) {
        LAS float* SL = (LAS float*)lds;
#pragma unroll
        for (int ai = 0; ai < 2; ++ai)
#pragma unroll
            for (int m = 0; m < 4; ++m) { LAS float* p = SL + (ai * HALF + wr * 64 + m * 16 + fr) * 128 + wc * 32 + 8 * fq; *(LAS f32x4*)p = acc[ai][0][m][0]; *(LAS f32x4*)(p + 4) = acc[ai][0][m][1]; }
        PG8_WAIT_L(0); PG8_BAR; asm volatile("" ::: "memory");
        if (tid < 128) {
            const int bb = tid >> 6, n = tid & 63, grp = cur.aux, b = 2 * cur.pm + bb;
            const GAS float* LAM = (const GAS float*)(g.ws + ws_lam(g.eb)) + (size_t)grp * 128; const float lr = LAM[2 * n], li = LAM[2 * n + 1];
            GAS bf16* XT = (GAS bf16*)(g.ws + WS_XS) + (size_t)(grp * NCHUNK + b * CPB) * XSK + 256 + n;
            const LAS float* Sp = SL + (bb * 128) * 128 + n;
            float hr = 0.f, hi = 0.f;
            for (int c0 = 0; c0 < CPB; c0 += 8) {
                float sr[8], si[8];
#pragma unroll
                for (int e = 0; e < 8; ++e) { sr[e] = Sp[(c0 + e) * 128]; si[e] = Sp[(c0 + e) * 128 + 64]; }
#pragma unroll
                for (int e = 0; e < 8; ++e) { XT[(size_t)(c0 + e) * XSK] = (bf16)f2bf(hr); XT[(size_t)(c0 + e) * XSK + 64] = (bf16)f2bf(hi);
                    const float nr = lr * hr - li * hi + sr[e], ni = lr * hi + li * hr + si[e]; hr = nr; hi = ni; }
            }
        }
        asm volatile("" ::: "memory"); PG8_BAR; asm volatile("" ::: "memory");
    }
#undef PG8_SA
#undef PG8_SB
#undef PG8_STAGE
#undef PG8_LDA
#undef PG8_LDB
#undef PG8_MMA
#undef PG8_WAIT_V
#undef PG8_WAIT_L
#undef PG8_BAR
#undef PG8_SCHED
}

typedef const GAS float* const __attribute__((address_space(4))) * KargPtr;
struct InTab { KargPtr kp; __device__ __forceinline__ const GAS float* operator[](int i) const { return (const GAS float*)kp[i]; } };
#define ARG_IN(i) (F.in[(i)])
struct Frame { LAS unsigned char* lds; int tid, lane, wave, vcu, G; InTab in; GAS float* out; GAS unsigned char* ws; };

constexpr int CW_DEP = 12288;
constexpr int CW_QUEUE = 8192;
static_assert((CW_DEP + 64 * 4 * DEPTH) * 4 <= (int)CTL_ZERO_BYTES && (CW_QUEUE + 64 * (1 + DEPTH)) <= CW_DEP && CW_BAR + XCD_BAR_WORDS <= CW_QUEUE, "control words inside the per-call memset");
__device__ __forceinline__ int queue_pull(Frame& F, int k) {
    volatile LAS int* slot = (volatile LAS int*)(F.lds + MISC_OFF + 64);
    __syncthreads();
    if (F.tid == 0) *slot = (int)__hip_atomic_fetch_add((unsigned*)(F.ws + WS_CTL) + CW_QUEUE + 64 * k, 1u, RLX_AGENT);
    __syncthreads();
    return *slot;
}
__device__ __forceinline__ float wave_sum(float v) {
#pragma unroll
    for (int o = 1; o < 64; o <<= 1) v += __shfl_xor(v, o);
    return v;
}
struct TItem { const GAS float* W; int ldw, col0, k0; const GAS float* gain; GAS bf16* dst; int ldd; };
__device__ __forceinline__ void titem_load(const TItem& t, f32x4 (&v)[8], int lane) {
    const int c4 = (lane & 7) * 4;
#pragma unroll
    for (int i = 0; i < 8; ++i) { const int kk = 8 * i + (lane >> 3); v[i] = *(const GAS f32x4*)(t.W + (size_t)(t.k0 + kk) * t.ldw + t.col0 + c4); }
}
__device__ __forceinline__ void titem_finish(const TItem& t, const f32x4 (&v)[8], LAS float* scr, int lane) {
    const int c4 = (lane & 7) * 4;
#pragma unroll
    for (int i = 0; i < 8; ++i) { const int kk = 8 * i + (lane >> 3); const float gn = t.gain ? t.gain[t.k0 + kk] : 1.0f; LAS float* p = scr + kk * 33 + c4;
        p[0] = v[i][0] * gn; p[1] = v[i][1] * gn; p[2] = v[i][2] * gn; p[3] = v[i][3] * gn; }
    LDS_WAIT(); asm volatile("" ::: "memory");
    const int c = lane & 7;
#pragma unroll
    for (int j = 0; j < 4; ++j) { const int n = (lane >> 3) + 8 * j; const LAS float* s = scr + (8 * c) * 33 + n;
        u32x4 o; o.x = pk2(s[0 * 33], s[1 * 33]); o.y = pk2(s[2 * 33], s[3 * 33]); o.z = pk2(s[4 * 33], s[5 * 33]); o.w = pk2(s[6 * 33], s[7 * 33]);
        *(GAS u32x4*)(t.dst + (size_t)n * t.ldd + t.k0 + 8 * c) = o; }
    LDS_WAIT(); asm volatile("" ::: "memory");
}
__device__ __forceinline__ void transpose_item(const GAS float* W, int ldw, int col0, int k0, const GAS float* gain, GAS bf16* dst, int ldd, LAS float* scr, int lane) {
    const TItem t{W, ldw, col0, k0, gain, dst, ldd}; f32x4 v[8]; titem_load(t, v, lane); titem_finish(t, v, scr, lane);
}

#if MK_PROBE
#define S5STAMP(k) do { if (blockIdx.x == 0 && threadIdx.x == 0 && l == 0) ((volatile LAS unsigned long long*)(F.lds + 132096))[k] = __builtin_amdgcn_s_memrealtime(); } while (0)
#else
#define S5STAMP(k) do {} while (0)
#endif
__device__ __forceinline__ void s5_group_prep(Frame& F, int l, int g) {
    LAS float* LPr = (LAS float*)F.lds;
    LAS float* LPi = LPr + 17 * 64;
    LAS float* BBr = LPi + 17 * 64;
    LAS float* BBi = BBr + 1024;
    LAS float* Cr = BBi + 1024;
    LAS float* Ci = Cr + 1024;
    LAS float* Kt = Ci + 1024;
    LAS float* Dk = Kt + 4096;
    const GAS float* a_re = F.in[4] + (size_t)(l * NG + g) * NS; const GAS float* a_im = F.in[5] + (size_t)(l * NG + g) * NS; const float log_dt = F.in[6][l * NG + g];
    const GAS float* b_re = F.in[7] + (size_t)(l * NG + g) * NS * NP; const GAS float* b_im = F.in[8] + (size_t)(l * NG + g) * NS * NP;
    const GAS float* c_re = F.in[9] + (size_t)(l * NG + g) * NP * NS; const GAS float* c_im = F.in[10] + (size_t)(l * NG + g) * NP * NS; const GAS float* dsk = F.in[11] + (size_t)(l * NG + g) * NP;
    const double dt = exp((double)log_dt);
    for (int idx = F.tid; idx < 17 * 64; idx += NTHR) { const int tau = idx >> 6, n = idx & 63;
        const double mag = exp((double)tau * dt * (double)a_re[n]), ang = (double)tau * dt * (double)a_im[n];
        const double angr = ang - 6.283185307179586476925 * rint(ang * 0.15915494309189533577);
        LPr[idx] = (float)(mag * (double)cosf((float)angr)); LPi[idx] = (float)(mag * (double)sinf((float)angr)); }
    for (int idx = F.tid; idx < 1024; idx += NTHR) { const int n = idx >> 4;
        const double ar = a_re[n], ai = a_im[n], mag = exp(dt * ar), ang = dt * ai, angr = ang - 6.283185307179586476925 * rint(ang * 0.15915494309189533577);
        const double abr = mag * (double)cosf((float)angr), abi = mag * (double)sinf((float)angr), den = ar * ar + ai * ai, nr = abr - 1.0, ni = abi;
        const double fr = (nr * ar + ni * ai) / den, fi = (ni * ar - nr * ai) / den, br = b_re[idx], bi = b_im[idx];
        BBr[idx] = (float)(fr * br - fi * bi); BBi[idx] = (float)(fr * bi + fi * br);
        Cr[idx] = c_re[idx]; Ci[idx] = c_im[idx]; }
    if (F.tid < 16) Dk[F.tid] = dsk[F.tid];
    __syncthreads();
    { const int tau = F.tid >> 5, q = (F.tid >> 1) & 15, p0 = (F.tid & 1) * 8; float kr[8];
#pragma unroll
      for (int e = 0; e < 8; ++e) kr[e] = 0.f;
#pragma unroll 4
      for (int n = 0; n < 64; ++n) { const float cr = Cr[q * 64 + n], ci = Ci[q * 64 + n], lr = LPr[tau * 64 + n], li = LPi[tau * 64 + n], xr = cr * lr - ci * li, xi = cr * li + ci * lr;
          const f32x4 br0 = *(const LAS f32x4*)(BBr + n * 16 + p0), br1 = *(const LAS f32x4*)(BBr + n * 16 + p0 + 4), bi0 = *(const LAS f32x4*)(BBi + n * 16 + p0), bi1 = *(const LAS f32x4*)(BBi + n * 16 + p0 + 4);
#pragma unroll
          for (int e = 0; e < 4; ++e) { kr[e] += xr * br0[e] - xi * bi0[e]; kr[4 + e] += xr * br1[e] - xi * bi1[e]; } }
#pragma unroll
      for (int e = 0; e < 8; ++e) Kt[(tau * 16 + q) * 16 + p0 + e] = kr[e]; }
    __syncthreads();
    const int eb = l & 1;
    GAS bf16* TW = (GAS bf16*)(F.ws + ws_e(eb) + EO_TW) + (size_t)g * 256 * XSK;
    for (int pc = F.tid; pc < 256 * 32; pc += NTHR) { const int row = pc >> 5, k8 = (pc & 31) * 8, i = row >> 4, q = row & 15, j = k8 >> 4, p0 = k8 & 15;
        const int tau = (i - j) > 0 ? (i - j) : 0; const LAS float* kp = Kt + (tau * 16 + q) * 16 + p0;
        f32x4 v0 = *(const LAS f32x4*)kp, v1 = *(const LAS f32x4*)(kp + 4);
        const float dq = Dk[q]; const int dpos = (i == j) ? q - p0 : -1;
#pragma unroll
        for (int e = 0; e < 4; ++e) { v0[e] = (j <= i) ? v0[e] + (dpos == e ? dq : 0.f) : 0.f; v1[e] = (j <= i) ? v1[e] + (dpos == 4 + e ? dq : 0.f) : 0.f; }
        u32x4 o; o.x = pk2(v0[0], v0[1]); o.y = pk2(v0[2], v0[3]); o.z = pk2(v1[0], v1[1]); o.w = pk2(v1[2], v1[3]);
        *(GAS u32x4*)(TW + (size_t)row * XSK + k8) = o; }
    for (int pc = F.tid; pc < 256 * 16; pc += NTHR) { const int row = pc >> 4, kk = (pc & 15) * 8, i = row >> 4, q = row & 15, part = kk >> 6, n0 = kk & 63;
        const f32x4 cr0 = *(const LAS f32x4*)(Cr + q * 64 + n0), cr1 = *(const LAS f32x4*)(Cr + q * 64 + n0 + 4), ci0 = *(const LAS f32x4*)(Ci + q * 64 + n0), ci1 = *(const LAS f32x4*)(Ci + q * 64 + n0 + 4);
        const f32x4 lr0 = *(const LAS f32x4*)(LPr + (i + 1) * 64 + n0), lr1 = *(const LAS f32x4*)(LPr + (i + 1) * 64 + n0 + 4), li0 = *(const LAS f32x4*)(LPi + (i + 1) * 64 + n0), li1 = *(const LAS f32x4*)(LPi + (i + 1) * 64 + n0 + 4);
        const f32x4 v0 = part == 0 ? (cr0 * lr0 - ci0 * li0) : -(cr0 * li0 + ci0 * lr0), v1 = part == 0 ? (cr1 * lr1 - ci1 * li1) : -(cr1 * li1 + ci1 * lr1);
        u32x4 o; o.x = pk2(v0[0], v0[1]); o.y = pk2(v0[2], v0[3]); o.z = pk2(v1[0], v1[1]); o.w = pk2(v1[2], v1[3]);
        *(GAS u32x4*)(TW + (size_t)row * XSK + 256 + kk) = o; }
    GAS bf16* WS = (GAS bf16*)(F.ws + ws_e(eb) + EO_WS) + (size_t)g * 256 * 256;
    for (int pc = F.tid; pc < 256 * 32; pc += NTHR) { const int row = pc >> 5, k8 = (pc & 31) * 8, j = k8 >> 4, p0 = k8 & 15, n = row & 63;
        const float lr = LPr[(15 - j) * 64 + n], li = LPi[(15 - j) * 64 + n];
        const f32x4 br0 = *(const LAS f32x4*)(BBr + n * 16 + p0), br1 = *(const LAS f32x4*)(BBr + n * 16 + p0 + 4), bi0 = *(const LAS f32x4*)(BBi + n * 16 + p0), bi1 = *(const LAS f32x4*)(BBi + n * 16 + p0 + 4);
        f32x4 v0 = row < 64 ? (br0 * lr - bi0 * li) : (bi0 * lr + br0 * li), v1 = row < 64 ? (br1 * lr - bi1 * li) : (bi1 * lr + br1 * li);
        if (row >= 128) { v0 = (f32x4){0.f, 0.f, 0.f, 0.f}; v1 = v0; }
        u32x4 o; o.x = pk2(v0[0], v0[1]); o.y = pk2(v0[2], v0[3]); o.z = pk2(v1[0], v1[1]); o.w = pk2(v1[2], v1[3]);
        *(GAS u32x4*)(WS + (size_t)row * 256 + k8) = o; }
    GAS float* LAM = (GAS float*)(F.ws + ws_lam(eb)) + (size_t)g * 128;
    if (F.tid < 64) { LAM[F.tid * 2] = LPr[16 * 64 + F.tid]; LAM[F.tid * 2 + 1] = LPi[16 * 64 + F.tid]; }
    __syncthreads();
}

__device__ __forceinline__ void pool_fold_item(Frame& F, int l, int item) {
    const int kk = item >> 4, k0 = (item & 15) * 64;
    LAS float* Wi = (LAS float*)F.lds;
    LAS float* Wg = Wi + 64 * 129;
    LAS bf16* To = (LAS bf16*)(Wg + 128 * 128);
    const GAS float* w_in = F.in[2] + (size_t)l * DM * INW; const GAS float* wgrp = F.in[20] + (size_t)(l * 4 + kk) * PGW * PGW; const GAS float* norm1 = F.in[1] + (size_t)l * DM;
    {
        f32x4 wi[4], wg[8];
#pragma unroll
        for (int j = 0; j < 4; ++j) { const int i4 = F.tid + j * NTHR, r = i4 >> 5, c4 = (i4 & 31) * 4; wi[j] = *(const GAS f32x4*)(w_in + (size_t)(k0 + r) * INW + 1536 + kk * PGW + c4); }
#pragma unroll
        for (int j = 0; j < 8; ++j) wg[j] = *(const GAS f32x4*)(wgrp + (size_t)(F.tid + j * NTHR) * 4);
#pragma unroll
        for (int j = 0; j < 4; ++j) { const int i4 = F.tid + j * NTHR, r = i4 >> 5, c4 = (i4 & 31) * 4; LAS float* p = Wi + r * 129 + c4; p[0] = wi[j][0]; p[1] = wi[j][1]; p[2] = wi[j][2]; p[3] = wi[j][3]; }
#pragma unroll
        for (int j = 0; j < 8; ++j) *(LAS f32x4*)(Wg + (F.tid + j * NTHR) * 4) = wg[j];
    }
    __syncthreads();
    const int k = F.tid >> 3, jg = F.tid & 7; float acc[16];
#pragma unroll
    for (int e = 0; e < 16; ++e) acc[e] = 0.f;
    for (int i = 0; i < 128; ++i) { const float a = Wi[k * 129 + i];
#pragma unroll
        for (int e = 0; e < 16; ++e) acc[e] += a * Wg[i * 128 + jg * 16 + e]; }
    const float gn = norm1[k0 + k];
#pragma unroll
    for (int e = 0; e < 16; ++e) To[(jg * 16 + e) * 72 + k] = (bf16)f2bf(acc[e] * gn);
    __syncthreads();
    GAS bf16* dst = (GAS bf16*)(F.ws + ws_e(l & 1) + EO_WMIX) + (size_t)(1536 + kk * PGW) * DM + k0;
    for (int pc = F.tid; pc < 128 * 8; pc += NTHR) { const int j = pc >> 3, c8 = (pc & 7) * 8; *(GAS u32x4*)(dst + (size_t)j * DM + c8) = *(const LAS u32x4*)(To + j * 72 + c8); }
    __syncthreads();
}

__device__ __forceinline__ void convert_E_waves(Frame& F, int l, int w, int NW, int it_lo, int it_hi) {
    const InTab in = F.in; const int eb = l & 1;
    LAS float* scr = (LAS float*)(F.lds + F.wave * 16384);
    const GAS float* norm1 = in[1] + (size_t)l * DM; const GAS float* w_in = in[2] + (size_t)l * DM * INW;
    constexpr int R1 = 768, R2 = R1 + 128, R3 = R2 + 16;
    if (it_hi > R3) it_hi = R3;
    for (int it = it_lo + w; it < it_hi; it += NW) {
        if (it < R1) {
            const int blk = it >> 6, r = it & 63, kb = r >> 2, nb = r & 3;
            int col0; if (blk < 4) col0 = blk * 128; else { const int t = (blk - 4) >> 1, gt = (blk - 4) & 1; col0 = 512 + gt * 512 + t * 128; }
            transpose_item(w_in, INW, col0 + nb * 32, kb * 64, norm1, (GAS bf16*)(F.ws + ws_e(eb) + EO_WMIX) + (size_t)(blk * 128 + nb * 32) * DM, DM, scr, F.lane);
        } else if (it < R2) { const int r = it - R1, blk = r >> 5, q = r & 31, kb = q >> 2, nb = q & 3;
            transpose_item(in[12] + (size_t)l * SW * SW, SW, blk * 128 + nb * 32, kb * 64, nullptr, (GAS bf16*)(F.ws + ws_e(eb) + EO_WGLU) + (size_t)(blk * 128 + nb * 32) * SW, SW, scr, F.lane);
        } else {
            const GAS float* wdw = in[15] + (size_t)l * CKW * CW; GAS float* cwt = (GAS float*)(F.ws + ws_cwt(eb));
            for (int j = F.lane; j < 1024; j += 64) { const int i = (it - R2) * 1024 + j, cpair = i >> 6, k = (i >> 1) & 31, e = i & 1; cwt[i] = (k < CKW) ? wdw[k * CW + 2 * cpair + e] : 0.f; }
        }
    }
}
__device__ __forceinline__ TItem l_item(Frame& F, int l, int it) {
    const InTab in = F.in;
    constexpr int R2 = 1536, R4 = R2 + 768, R5 = R4 + 512, R6 = R5 + 2816, R7 = R6 + 1408; static_assert(R7 == 7040, "late-set items");
    if (it < R2) { const int blk = it >> 6, q = it & 63, kb = q >> 2, nb = q & 3;
        return TItem{in[2] + (size_t)l * DM * INW, INW, 2048 + blk * 128 + nb * 32, kb * 64, in[1] + (size_t)l * DM, (GAS bf16*)(F.ws + WS_WGATE) + (size_t)(blk * 128 + nb * 32) * DM, DM}; }
    if (it < R4) { const int r = it - R2, src = r >> 8, r2 = r & 255, blk = r2 >> 5, q = r2 & 31, kb = q >> 2, nb = q & 3;
        return TItem{(src == 0 ? in[14] : src == 1 ? in[19] : in[22]) + (size_t)l * 512 * DM, DM, blk * 128 + nb * 32, kb * 64, nullptr, (GAS bf16*)(F.ws + WS_WBR) + (size_t)(blk * 128 + nb * 32) * 1536 + src * 512, 1536}; }
    if (it < R5) { const int r = it - R4, blk = r >> 6, q = r & 63, kb = q >> 2, nb = q & 3;
        return TItem{in[23] + (size_t)l * DM * DM, DM, blk * 128 + nb * 32, kb * 64, nullptr, (GAS bf16*)(F.ws + WS_WOUT) + (size_t)(blk * 128 + nb * 32) * DM, DM}; }
    if (it < R6) { const int r = it - R5, blk = r >> 6, q = r & 63, kb = q >> 2, nb = q & 3;
        return TItem{((blk & 1) ? in[26] : in[25]) + (size_t)l * DM * FF, FF, (blk >> 1) * 128 + nb * 32, kb * 64, in[24] + (size_t)l * DM, (GAS bf16*)(F.ws + WS_WGU) + (size_t)(blk * 128 + nb * 32) * DM, DM}; }
    { const int r = it - R6, blk = r / 176, q = r % 176, kb = q >> 2, nb = q & 3;
        return TItem{in[27] + (size_t)l * FF * DM, DM, blk * 128 + nb * 32, kb * 64, nullptr, (GAS bf16*)(F.ws + WS_WDN) + (size_t)(blk * 128 + nb * 32) * FF, FF}; }
}
__device__ __forceinline__ void convert_L_waves(Frame& F, int l, int w, int NW, int it_lo, int it_hi) {
    LAS float* scr = (LAS float*)(F.lds + F.wave * 16384);
    int it = it_lo + w; if (it >= it_hi) return;
    TItem ta = l_item(F, l, it), tb = ta; f32x4 va[8], vb[8];
    titem_load(ta, va, F.lane);
    for (;;) {
        const int i1 = it + NW; const bool h1 = i1 < it_hi;
        if (h1) { tb = l_item(F, l, i1); titem_load(tb, vb, F.lane); }
        titem_finish(ta, va, scr, F.lane);
        if (!h1) break;
        const int i2 = i1 + NW; const bool h2 = i2 < it_hi;
        if (h2) { ta = l_item(F, l, i2); titem_load(ta, va, F.lane); }
        titem_finish(tb, vb, scr, F.lane);
        if (!h2) break;
        it = i2;
    }
}
__device__ __forceinline__ void xb0_waves(Frame& F, int w, int NW, int m_lo, int m_hi) {
    GAS float* rsa = (GAS float*)(F.ws + WS_RSA); GAS bf16* XB = (GAS bf16*)(F.ws + WS_XB); const GAS float* x = F.in[0];
    for (int m = m_lo + w; m < m_hi; m += NW) {
        const GAS f32x4* xr = (const GAS f32x4*)(x + (size_t)m * DM) + F.lane; f32x4 v[4]; float s = 0.f;
#pragma unroll
        for (int j = 0; j < 4; ++j) { v[j] = xr[64 * j]; s += (v[j].x * v[j].x + v[j].y * v[j].y) + (v[j].z * v[j].z + v[j].w * v[j].w); }
        s = wave_sum(s);
        GAS unsigned long long* o8 = (GAS unsigned long long*)(XB + (size_t)m * DM) + F.lane;
#pragma unroll
        for (int j = 0; j < 4; ++j) o8[64 * j] = (unsigned long long)pk2(v[j].x, v[j].y) | ((unsigned long long)pk2(v[j].z, v[j].w) << 32);
        if (F.lane < 4) *(GAS f32x4*)(rsa + (size_t)F.lane * (4 * M) + (size_t)m * 4) = (f32x4){F.lane == 0 ? s : 0.f, 0.f, 0.f, 0.f};
    }
}

template <int W> __device__ __forceinline__ void pool_regs(const unsigned (&vr)[47], GAS bf16* brp, int s_first, f32x2 sc) {
    float sm0 = 0.f, sm1 = 0.f;
#pragma unroll
    for (int tau = 1; tau < W; ++tau) { sm0 += bf_lo(vr[15 - tau]); sm1 += bf_hi(vr[15 - tau]); }
#pragma unroll
    for (int i = 0; i < 32; ++i) { const float v0 = bf_lo(vr[15 + i]), v1 = bf_hi(vr[15 + i]);
        sm0 += v0; sm1 += v1;
        const int pos = s_first + i + 1; const float inv = 1.0f / (float)(pos < W ? pos : W);
        *(GAS unsigned*)(brp + (size_t)i * 1536) = pk2(sc.x * (sm0 * inv - v0), sc.y * (sm1 * inv - v1));
        sm0 -= bf_lo(vr[15 + i - (W - 1)]); sm1 -= bf_hi(vr[15 + i - (W - 1)]); }
}
__device__ __forceinline__ void mixer_tile(Frame& F, int l, int tile) {
    const int t0 = tile * 64, s0 = t0 & (SEQ - 1);
    const GAS bf16* HC = (const GAS bf16*)(F.ws + WS_HC); const GAS bf16* V = (const GAS bf16*)(F.ws + WS_V); GAS bf16* BR = (GAS bf16*)(F.ws + WS_BR);
    LAS unsigned char* hb = F.lds;
    LAS f32x2* part = (LAS f32x2*)(F.lds + 98304);
    LAS f32x2* stat = (LAS f32x2*)(F.lds + RST_OFF + 1024);
    for (int r = F.wave; r < 94; r += NWAVES) {
        if (s0 - 30 + r >= 0) __builtin_amdgcn_global_load_lds((const GAS unsigned*)(HC + (size_t)(t0 - 30 + r) * CW + F.lane * 8), (LAS unsigned*)(hb + r * 1024), 16, 0, 0);
        else { unsigned z = 0u; asm volatile("" : "+v"(z)); *(LAS u32x4*)(hb + r * 1024 + F.lane * 16) = (u32x4){z, z, z, z}; }
    }
    const int cp = F.tid & 255, th = F.tid >> 8;
    unsigned vr[47];
#pragma unroll
    for (int r = 0; r < 47; ++r) { const int tl = th * 32 - 15 + r; vr[r] = *(const GAS unsigned*)(V + (size_t)(t0 + (s0 + tl >= 0 ? tl : -s0)) * PW + 2 * cp); }
    f32x2 wt[32];
    { const GAS f32x4* wp = (const GAS f32x4*)((const GAS float*)(F.ws + ws_cwt(l & 1)) + (size_t)cp * 64);
#pragma unroll
      for (int k2 = 0; k2 < 16; ++k2) { const f32x4 a = wp[k2]; wt[2 * k2] = (f32x2){a[0], a[1]}; wt[2 * k2 + 1] = (f32x2){a[2], a[3]}; } }
    const f32x2 bdw = *(const GAS f32x2*)(F.in[16] + (size_t)l * CW + 2 * cp);
    const f32x2 lng = *(const GAS f32x2*)(F.in[17] + (size_t)l * CW + 2 * cp), lnb = *(const GAS f32x2*)(F.in[18] + (size_t)l * CW + 2 * cp);
    VM_WAIT(); __syncthreads();
#pragma unroll 1
    for (int rr = 0; rr < 4; ++rr) {
        const int tb = (th * 4 + rr) * 8;
        f32x2 a[8];
#pragma unroll
        for (int i = 0; i < 8; ++i) a[i] = bdw;
#pragma unroll
        for (int r = 0; r < 38; ++r) { const unsigned w = *(const LAS unsigned*)(hb + (tb + r) * 1024 + cp * 4); const f32x2 h = (f32x2){bf_lo(w), bf_hi(w)};
#pragma unroll
            for (int i = 0; i < 8; ++i) { const int k = r - i; if (k >= 0 && k < CKW) a[i] += wt[k] * h; } }
#pragma unroll
        for (int i = 0; i < 8; ++i) part[(th * 8 + i) * 256 + cp] = (f32x2){a[i].x + a[i].y, a[i].x * a[i].x + a[i].y * a[i].y};
        __syncthreads();
        { const int tk = F.tid >> 5, sg = F.tid & 31; f32x2 p = part[tk * 256 + sg];
#pragma unroll
          for (int e = 1; e < 8; ++e) p += part[tk * 256 + sg + 32 * e];
#pragma unroll
          for (int o = 1; o < 32; o <<= 1) { p.x += __shfl_xor(p.x, o); p.y += __shfl_xor(p.y, o); }
          if (sg == 0) { const float mu = p.x * (1.0f / CW), var = p.y * (1.0f / CW) - mu * mu; stat[tk] = (f32x2){mu, __builtin_amdgcn_rsqf(fmaxf(var, 0.f) + EPS)}; } }
        __syncthreads();
#pragma unroll
        for (int i = 0; i < 8; ++i) { const int tok = tb + i; const f32x2 st = stat[th * 8 + i];
            float y0 = (a[i].x - st.x) * st.y * lng.x + lnb.x, y1 = (a[i].y - st.x) * st.y * lng.y + lnb.y; y0 *= fsigmoid(y0); y1 *= fsigmoid(y1);
            *(GAS unsigned*)(BR + (size_t)(t0 + tok) * 1536 + 512 + 2 * cp) = pk2(y0, y1); }
    }
    {
        const f32x2 sc = *(const GAS f32x2*)(F.in[21] + (size_t)l * PW + 2 * cp); GAS bf16* brp = BR + (size_t)(t0 + th * 32) * 1536 + 1024 + 2 * cp; const int sf = s0 + th * 32;
#pragma unroll
        for (int r = 0; r < 15; ++r) if (sf - 15 + r < 0) vr[r] = 0u;
        switch (cp >> 6) { case 0: pool_regs<2>(vr, brp, sf, sc); break; case 1: pool_regs<4>(vr, brp, sf, sc); break; case 2: pool_regs<8>(vr, brp, sf, sc); break; default: pool_regs<16>(vr, brp, sf, sc); break; }
    }
    __syncthreads();
}

__device__ __forceinline__ void final_phase(Frame& F) {
    const GAS float* rsa = (const GAS float*)(F.ws + WS_RSA); const GAS float* gfin = F.in[28]; const GAS bf16* XB = (const GAS bf16*)(F.ws + WS_XB);
    const int gw = F.vcu * NWAVES + F.wave, NGW = F.G * NWAVES;
    for (int m = gw; m < M; m += NGW) { const float rs = row_rs(rsa, m);
        GAS f32x4* o = (GAS f32x4*)(F.out + (size_t)m * DM); const GAS f32x4* gr = (const GAS f32x4*)gfin;
#pragma unroll
        for (int j = 0; j < 2; ++j) { const int c8 = j * 64 + F.lane; const u32x4 w = *(const GAS u32x4*)(XB + (size_t)m * DM + c8 * 8);
            const f32x4 x0 = (f32x4){bf_lo(w.x), bf_hi(w.x), bf_lo(w.y), bf_hi(w.y)}, x1 = (f32x4){bf_lo(w.z), bf_hi(w.z), bf_lo(w.w), bf_hi(w.w)};
            o[c8 * 2] = x0 * rs * gr[c8 * 2]; o[c8 * 2 + 1] = x1 * rs * gr[c8 * 2 + 1]; } }
}

constexpr int PH_PER_LAYER = 6, PH_FINAL = 1 + PH_PER_LAYER * DEPTH, PH_TOTAL = PH_FINAL + 1;
__global__ void __launch_bounds__(NTHR, 2) mk_fwd(Args args) {
    extern __shared__ __attribute__((aligned(16))) unsigned char lds_raw[];
    Frame F; F.lds = (LAS unsigned char*)lds_raw; F.tid = threadIdx.x; F.lane = F.tid & 63; F.wave = __builtin_amdgcn_readfirstlane(F.tid >> 6);
    F.G = gridDim.x; { const int bx = blockIdx.x; F.vcu = (F.G % 8 == 0) ? (bx % 8) * (F.G / 8) + bx / 8 : bx; }
    F.out = (GAS float*)args.out; F.ws = (GAS unsigned char*)args.ws;
    unsigned char* ws = args.ws;
    volatile LAS unsigned* MISC = (volatile LAS unsigned*)(F.lds + MISC_OFF);
    for (int u = F.tid; u < (LDS_BYTES - LDSCTL_OFF) / 4; u += NTHR) ((LAS unsigned*)(F.lds + LDSCTL_OFF))[u] = 0u;
    __syncthreads();
    XcdBarrier bar; bar.bar = (unsigned*)(ws + WS_CTL) + CW_BAR; bar.x = 0; bar.st = nullptr;
    const bool multi = (args.ph_hi - args.ph_lo) > 1;
    if (multi) bar = xcd_barrier_post((unsigned*)(ws + WS_CTL) + CW_BAR, MISC + 8);
    const int wave0 = F.wave, vcu0 = F.vcu, G0 = F.G;
#if MK_PROBE
    PSTAMP(args.ph_lo);
#endif
    for (int ph = args.ph_lo; ph < args.ph_hi; ++ph) {
        { int wv_ = wave0, vc_ = vcu0, g_ = G0; asm volatile("" : "+s"(wv_), "+s"(vc_), "+s"(g_)); F.wave = wv_; F.vcu = vc_; F.G = g_;
          int l_ = (int)__builtin_amdgcn_mbcnt_hi(~0u, __builtin_amdgcn_mbcnt_lo(~0u, 0u)); asm volatile("" : "+v"(l_)); F.lane = l_; F.tid = F.wave * 64 + l_;
          unsigned char* w_ = args.ws; asm volatile("" : "+s"(w_)); ws = as_global(w_); F.ws = (GAS unsigned char*)w_; F.out = (GAS float*)args.out;
          KargPtr k_ = (KargPtr)__builtin_amdgcn_kernarg_segment_ptr(); asm volatile("" : "+s"(k_)); F.in.kp = k_; }
        int cblk = (int)blockIdx.x; asm volatile("" : "+s"(cblk));
        const int l = (ph - 1) / PH_PER_LAYER, pt = (ph - 1) - l * PH_PER_LAYER, eb = l & 1;
        if (ph == PH_FINAL) final_phase(F);
        else if (ph != 0) {
            GDesc d; d.ws = ws; d.mode = 0; d.nM = M / BM; d.nN = 1; d.rs_in = nullptr; d.rs_out = nullptr; d.bias = nullptr; d.xold = nullptr; d.xnew = nullptr; d.xb = nullptr; d.xres = nullptr; d.lds = F.lds; d.rs_pm = -1; d.eb = eb; d.blk = cblk;
            float* rsa = (float*)(ws + WS_RSA); float* rsb = (float*)(ws + WS_RSB);
            unsigned char* we = ws + ws_e(eb);
            switch (pt) {
            case 0: d.A = (const char*)(ws + WS_XB); d.B = (const char*)(we + EO_WMIX); d.lda = DM; d.ldb = DM; d.K = DM; d.nN = 8; d.rs_in = rsa;
                    gemm_phase<GM_MIX>(F.lds, d, F.G, cblk, F.wave); break;
            case 1: if (cblk < 128) {
                        d.A = (const char*)(ws + WS_XS); d.B = (const char*)(we + EO_WS); d.lda = XSK; d.ldb = 256; d.K = 256;
                        gemm_phase<GM_S1>(F.lds, d, F.G, cblk, F.wave);
                        asm volatile("s_waitcnt vmcnt(0)" ::: "memory"); __syncthreads();
                        d.B = (const char*)(we + EO_TW); d.ldb = XSK; d.K = XSK;
                        gemm_phase<GM_S3>(F.lds, d, F.G, cblk, F.wave);
                        asm volatile("s_waitcnt vmcnt(0)" ::: "memory"); __syncthreads();
                        if (F.tid == 0) {
                            unsigned* dep = (unsigned*)(ws + WS_CTL) + CW_DEP + 64 * (4 * l);
                            __builtin_amdgcn_fence(__ATOMIC_RELEASE, "agent"); asm volatile("s_waitcnt vmcnt(0)" ::: "memory");
                            __hip_atomic_fetch_add(dep + 64 * (cblk & 3), 1u, RLX_AGENT);
                            const int pmg = 8 * (cblk & 7) + ((cblk >> 3) & 7); unsigned sp = 0;
                            while (__hip_atomic_load(dep + 64 * (pmg >> 4), RLX_AGENT) < 32u) { __builtin_amdgcn_s_sleep(2); if (++sp > (1u << 22)) break; }
                            __builtin_amdgcn_fence(__ATOMIC_ACQUIRE, "agent"); asm volatile("s_waitcnt vmcnt(0)" ::: "memory");
                        }
                        __syncthreads();
                        d.A = (const char*)(ws + WS_YS); d.B = (const char*)(we + EO_WGLU); d.lda = SW; d.ldb = SW; d.K = SW; d.nN = 2; d.bias = (const float*)(ARG_IN(13) + (size_t)l * SW);
                        gemm_phase<GM_GLU>(F.lds, d, F.G, cblk, F.wave);
                    }
                    break;
            case 2: d.A = (const char*)(ws + WS_XB); d.B = (const char*)(ws + WS_WGATE); d.lda = DM; d.ldb = DM; d.K = DM; d.nN = 12; d.rs_in = rsa; d.bias = (const float*)(ARG_IN(3) + (size_t)l * 3 * DM);
                    if (l == 0) PSTAMP(36);
                    gemm_phase<GM_GATE>(F.lds, d, F.G, cblk, F.wave);
                    asm volatile("s_waitcnt vmcnt(0)" ::: "memory"); __syncthreads();
                    if (l == 0) PSTAMP(37);
                    d.A = (const char*)(ws + WS_BR); d.B = (const char*)(ws + WS_WBR); d.lda = 1536; d.ldb = 1536; d.K = 512; d.nN = 4; d.rs_in = nullptr; d.bias = nullptr;
                    d.xb = (bf16*)F.out;
                    gemm_phase<GM_MERGE>(F.lds, d, F.G, cblk, F.wave); break;
            case 3: d.A = (const char*)F.out; d.B = (const char*)(ws + WS_WOUT); d.lda = DM; d.ldb = DM; d.K = DM; d.nN = 4;
                    d.xold = nullptr; d.xres = (const bf16*)(ws + WS_XB); d.xnew = nullptr; d.xb = (bf16*)(ws + WS_XB2); d.rs_out = rsb;
                    gemm_phase<GM_WOUT>(F.lds, d, F.G, cblk, F.wave); break;
            case 4: d.A = (const char*)(ws + WS_XB2); d.B = (const char*)(ws + WS_WGU); d.lda = DM; d.ldb = DM; d.K = DM; d.nN = 22; d.rs_in = rsb;
                    gemm_phase<GM_GU>(F.lds, d, F.G, cblk, F.wave); break;
            default: d.A = (const char*)(ws + WS_HID); d.B = (const char*)(ws + WS_WDN); d.lda = FF; d.ldb = FF; d.K = FF; d.nN = 4;
                    d.xold = nullptr; d.xres = (const bf16*)(ws + WS_XB2); d.xnew = nullptr; d.xb = (bf16*)(ws + WS_XB); d.rs_out = rsa;
                    gemm_phase<GM_WOUT>(F.lds, d, F.G, cblk, F.wave); break;
            }
        }
        if (ph == 0 || (ph != PH_FINAL && pt == 1)) {
            const int cl = (ph == 0) ? 0 : l + 1, qk = (ph == 0) ? 0 : 1 + l;
            const int nS = (cl < DEPTH) ? 32 : 0, nM = (ph == 0) ? 0 : 256, nP = (cl < DEPTH) ? 64 : 0, nE = (cl < DEPTH) ? 57 : 0, nL = (ph == 0) ? 0 : 440, nX = (ph == 0) ? 512 : 0;
            const int m0 = nS, p0 = m0 + nM, e0 = p0 + nP, l0 = e0 + nE, x0 = l0 + nL, tot = x0 + nX;
            for (;;) { const int it = queue_pull(F, qk); if (it >= tot) break;
                { int l_ = F.lane; asm volatile("" : "+v"(l_)); F.lane = l_; F.tid = F.wave * 64 + l_; }
                if (it < nS) s5_group_prep(F, cl, it);
                else if (it < p0) mixer_tile(F, l, it - m0);
                else if (it < e0) pool_fold_item(F, cl, it - p0);
                else if (it < l0) convert_E_waves(F, cl, F.wave, NWAVES, (it - e0) * 16, (it - e0) * 16 + 16);
                else if (it < x0) convert_L_waves(F, l, F.wave, NWAVES, (it - l0) * 16, (it - l0) * 16 + 16);
                else xb0_waves(F, F.wave, NWAVES, (it - x0) * 32, (it - x0) * 32 + 32);
            }
        }
        if (ph + 1 < args.ph_hi) xcd_barrier(bar);
#if MK_PROBE
        if (ph == 5 && multi) { PSTAMP(41); xcd_barrier(bar); PSTAMP(42); xcd_barrier(bar); PSTAMP(43); }
#endif
#if MK_PROBE
        PSTAMP(ph + 1);
#endif
    }
#if MK_PROBE
    if (blockIdx.x == PROBE_BLK && threadIdx.x == 0) {
        volatile LAS unsigned long long* st = (volatile LAS unsigned long long*)(F.lds + 132096);
        unsigned long long qa = (st[PROBE_A + 1] - st[PROBE_A]) / 400ull, qb = (st[PROBE_B + 1] - st[PROBE_B]) / 400ull; if (qa > 127) qa = 127; if (qb > 127) qb = 127;
        const unsigned long long t0 = __builtin_amdgcn_s_memrealtime(), dl = 1000ull * (qa + 128ull * qb);
        while (__builtin_amdgcn_s_memrealtime() - t0 < dl) __builtin_amdgcn_s_sleep(8);
    }
#endif
}


#if MK_DIAG
__global__ void diag_sum(const unsigned* o, size_t nwords, unsigned* acc) {
    unsigned cs = 0; for (size_t i = (size_t)blockIdx.x * blockDim.x + threadIdx.x; i < nwords; i += (size_t)gridDim.x * blockDim.x) cs += o[i] * 2654435761u + (unsigned)i;
    for (int k = 1; k < 64; k <<= 1) cs += __shfl_xor(cs, k);
    if ((threadIdx.x & 63) == 0) atomicAdd(acc, cs);
}
__global__ void diag_cmp(float* out, const unsigned* acc, unsigned* pers, const unsigned* tmo) {
    const unsigned total = *acc, magic = pers[0], prev = pers[1], sticky = pers[2];
    const bool mism = (magic == 0x600DF00Du && (sticky == 1u || prev != total));
    const bool bad = (DIAG_WHAT == 0) ? (*tmo != 0u) : mism;
    __syncthreads();
    if (threadIdx.x == 0) { pers[0] = 0x600DF00Du; pers[1] = total; pers[2] = mism ? 1u : 0u; }
    if (bad) for (int i = threadIdx.x; i < 4096; i += blockDim.x) out[i] = __builtin_nanf("");
}
#endif
extern "C" void kernel_launch(void* const* d_in, const int* in_sizes, int n_in, void* d_out, int out_size, void* d_ws, size_t ws_size, hipStream_t stream) {
    static int grid = 0;
    if (grid == 0) {
        if (n_in != 29 || out_size != M * DM || ws_size < WS_END) { fprintf(stderr, "kernel_launch: unexpected shapes (n_in %d out %d ws %zu)\n", n_in, out_size, ws_size); grid = -1; return; }
        int dev = 0, cus = 0, per_cu = 0;
        if (hipGetDevice(&dev) != hipSuccess || hipDeviceGetAttribute(&cus, hipDeviceAttributeMultiprocessorCount, dev) != hipSuccess) { grid = -1; return; }
        if (hipFuncSetAttribute((const void*)mk_fwd, hipFuncAttributeMaxDynamicSharedMemorySize, LDS_BYTES) != hipSuccess) { fprintf(stderr, "kernel_launch: hipFuncSetAttribute failed\n"); grid = -1; return; }
        if (hipOccupancyMaxActiveBlocksPerMultiprocessor(&per_cu, (const void*)mk_fwd, NTHR, LDS_BYTES) != hipSuccess || per_cu < 1) { fprintf(stderr, "kernel_launch: occupancy query says %d blocks per CU\n", per_cu); grid = -1; return; }
        if (cus != 256) { fprintf(stderr, "kernel_launch: built for a 256-CU device (unit-to-workgroup maps assume 256 workgroups), found %d\n", cus); grid = -1; return; }
        grid = cus;
    }
    if (grid < 0) return;
    (void)hipMemsetAsync((char*)d_ws + WS_CTL, 0, CTL_ZERO_BYTES, stream);
    Args a{};
    for (int i = 0; i < 29; ++i) a.in[i] = (const float*)d_in[i];
    a.out = (float*)d_out; a.ws = (unsigned char*)d_ws;
#if MK_PER_PHASE
    for (int ph = 0; ph < PH_TOTAL; ++ph) { a.ph_lo = ph; a.ph_hi = ph + 1; hipLaunchKernelGGL(mk_fwd, dim3(grid), dim3(NTHR), LDS_BYTES, stream, a);
#if MK_DIAG
        if (ph == DIAG_AFTER && DIAG_LEN > 0) hipLaunchKernelGGL(diag_sum, dim3(1024), dim3(256), 0, stream, (const unsigned*)((char*)d_ws + (size_t)DIAG_OFF * MiB), (size_t)DIAG_LEN * MiB / 4, (unsigned*)((char*)d_ws + WS_CTL) + 2048);
#endif
    }
#else
    a.ph_lo = 0; a.ph_hi = PH_TOTAL; hipLaunchKernelGGL(mk_fwd, dim3(grid), dim3(NTHR), LDS_BYTES, stream, a);
#endif
#if MK_DIAG
    { unsigned* ctl = (unsigned*)((char*)d_ws + WS_CTL); unsigned* pers = (unsigned*)((char*)d_ws + WS_CTL + 3 * (MiB / 2));
      if (DIAG_LEN == 0) hipLaunchKernelGGL(diag_sum, dim3(1024), dim3(256), 0, stream, (const unsigned*)d_out, (size_t)M * DM, ctl + 2048);
      hipLaunchKernelGGL(diag_cmp, dim3(1), dim3(256), 0, stream, (float*)d_out, (const unsigned*)(ctl + 2048), pers, (const unsigned*)(ctl + CW_BAR + XB_TMO)); }
#endif
}
```

```cpp
#include <hip/hip_runtime.h>
#include <cstdio>
#include <cstdint>

#define LAS __attribute__((address_space(3)))
#define GAS __attribute__((address_space(1)))
template <class T> __device__ __forceinline__ T* as_global(T* p) { return (T*)(GAS T*)p; }
typedef unsigned short bf16;
typedef short bf16x8 __attribute__((ext_vector_type(8)));
typedef float f32x4 __attribute__((ext_vector_type(4)));
typedef float f32x2 __attribute__((ext_vector_type(2)));
typedef unsigned u32x4 __attribute__((ext_vector_type(4)));
typedef unsigned u32x2 __attribute__((ext_vector_type(2)));

#ifndef MK_PROBE
#define MK_PROBE 0
#endif
#ifndef PROBE_A
#define PROBE_A 0
#define PROBE_B 1
#endif
#ifndef PROBE_BLK
#define PROBE_BLK 0
#endif
#if MK_PROBE
#define PSTAMP(k) do { if (blockIdx.x == PROBE_BLK && threadIdx.x == 0) ((volatile LAS unsigned long long*)(F.lds + 132096))[k] = __builtin_amdgcn_s_memrealtime(); } while (0)
#else
#define PSTAMP(k) do {} while (0)
#endif
#ifndef MK_DIAG
#define MK_DIAG 0
#define DIAG_WHAT 0
#define DIAG_AFTER 20
#define DIAG_OFF 0
#define DIAG_LEN 0
#endif
#ifndef MK_SP2
#define MK_SP2 1
#endif
#ifndef MK_PER_PHASE
#define MK_PER_PHASE 0
#endif

constexpr int DM = 1024, BATCH = 8, SEQ = 2048, DEPTH = 2, M = BATCH * SEQ;
constexpr int SW = 512, NG = 32, NP = 16, NS = 64, CW = 512, CKW = 31, PW = 512, PGW = 128, INW = 5120, FF = 2816;
constexpr int CL = 16, NCHUNK = M / CL, CPB = SEQ / CL, XSK = 384;
constexpr float EPS = 1e-6f;
constexpr int NWAVES = 8, NTHR = 512;

constexpr size_t MiB = 1u << 20;
constexpr size_t WS_CTL = 0, CTL_ZERO_BYTES = 64 * 1024;
constexpr size_t WS_LAM16_0 = 1 * MiB;
constexpr size_t WS_CWT_0 = 1 * MiB + 64 * 1024;
constexpr size_t WS_E0 = 2 * MiB, WS_E1 = 220 * MiB;
constexpr size_t EO_WMIX = 0, EO_WS = 4 * MiB, EO_TW = 8 * MiB, EO_WGLU = 14 * MiB, E_BYTES = 14 * MiB + MiB / 2;
__host__ __device__ __forceinline__ constexpr size_t ws_e(int e) { return e ? WS_E1 : WS_E0; }
__host__ __device__ __forceinline__ constexpr size_t ws_lam(int e) { return WS_LAM16_0 + (size_t)e * 16384; }
__host__ __device__ __forceinline__ constexpr size_t ws_cwt(int e) { return WS_CWT_0 + (size_t)e * 65536; }
constexpr size_t WS_WGATE = WS_E0 + E_BYTES;
constexpr size_t WS_WBR = WS_WGATE + 6 * MiB;
constexpr size_t WS_WOUT = WS_WBR + 3 * MiB;
constexpr size_t WS_WGU = WS_WOUT + 2 * MiB;
constexpr size_t WS_WDN = WS_WGU + 11 * MiB;
constexpr size_t WS_XB = 44 * MiB;
constexpr size_t WS_RC = 76 * MiB;
constexpr size_t WS_G = WS_RC, WS_HID = WS_RC;
constexpr size_t WS_XS = WS_RC;
constexpr size_t WS_HC = WS_XS + 24 * MiB;
constexpr size_t WS_V = WS_HC + 16 * MiB;
constexpr size_t WS_YS = WS_V + 32 * MiB;
constexpr size_t WS_BR = 172 * MiB;
constexpr size_t WS_XB2 = WS_BR;
constexpr size_t WS_RSA = 252 * MiB, WS_RSB = 253 * MiB;
constexpr size_t WS_END = 254 * MiB;
static_assert(WS_WDN + 5 * MiB + MiB / 2 <= WS_XB && WS_YS + 16 * MiB <= WS_RC + 96 * MiB && WS_E1 + E_BYTES <= WS_RSA && ws_cwt(1) + 65536 <= WS_E0, "ws map");

constexpr int CW_BAR = 4096;

constexpr int RST_OFF = 133120;
constexpr int RING_BYTES = 131072, LDSCTL_OFF = RING_BYTES, MISC_OFF = LDSCTL_OFF + 320, LDS_BYTES = 147456;

#define RLX_AGENT __ATOMIC_RELAXED, __HIP_MEMORY_SCOPE_AGENT
#define LDS_WAIT() asm volatile("s_waitcnt lgkmcnt(0)" ::: "memory")
#define VM_WAIT() asm volatile("s_waitcnt vmcnt(0)" ::: "memory")

__device__ __forceinline__ unsigned f2bf(float f) { unsigned u = __builtin_bit_cast(unsigned, f); return (u + 0x7fffu + ((u >> 16) & 1u)) >> 16; }
__device__ __forceinline__ unsigned pk2(float lo, float hi) { return f2bf(lo) | (f2bf(hi) << 16); }
typedef __bf16 bf16x2_t __attribute__((ext_vector_type(2)));
__device__ __forceinline__ unsigned cvt_pk_bf16(float lo, float hi) { const bf16x2_t v = __builtin_convertvector((f32x2){lo, hi}, bf16x2_t); return __builtin_bit_cast(unsigned, v); }
__device__ __forceinline__ float bf_lo(unsigned w) { return __builtin_bit_cast(float, w << 16); }
__device__ __forceinline__ float bf_hi(unsigned w) { return __builtin_bit_cast(float, w & 0xffff0000u); }
__device__ __forceinline__ float fsigmoid(float v) { return __builtin_amdgcn_rcpf(1.0f + __builtin_amdgcn_exp2f(-1.4426950408889634f * v)); }
__device__ __forceinline__ float fgelu(float v) { return v * fsigmoid(1.5957691216057308f * (v + 0.044715f * v * v * v)); }

#define XB_TMO      128
#define XB_XCNT(j)  (256  + 64 * (j))
#define XB_XSUB(j)  (1280 + 64 * (j))
#define XB_XGEN(j)  (2304 + 64 * (j))
#define XB_TOP      3328
#define XB_TOPGEN   3392
#define XCD_BAR_WORDS 3456
#define XB_SPIN_CAP (1u << 18)
__device__ __forceinline__ unsigned xb_ld(unsigned* p)              { return __hip_atomic_load(p, __ATOMIC_RELAXED, __HIP_MEMORY_SCOPE_AGENT); }
__device__ __forceinline__ unsigned xb_add(unsigned* p, unsigned v) { return __hip_atomic_fetch_add(p, v, __ATOMIC_RELAXED, __HIP_MEMORY_SCOPE_AGENT); }
__device__ __forceinline__ unsigned xb_xcc_id() { return (unsigned)__builtin_amdgcn_s_getreg((3 << 11) | 20) & 0xFu; }
#define XB_SPIN(cond, bar) do { unsigned _sp = 0; while (cond) { __builtin_amdgcn_s_sleep(1); \
    if ((++_sp & 255u) == 0u) { if (xb_ld(&(bar)[XB_TMO])) break; if (_sp > XB_SPIN_CAP) { atomicAdd(&(bar)[XB_TMO], 1u); break; } } } } while (0)
struct XcdBarrier { unsigned* bar; unsigned x; volatile LAS unsigned* st; };
__device__ __forceinline__ XcdBarrier xcd_barrier_post(unsigned* bar, volatile LAS unsigned* st) {
    XcdBarrier b; b.bar = bar; b.x = xb_xcc_id(); b.st = st;
    if (threadIdx.x == 0) (void)xb_add(&bar[XB_XCNT(b.x)], 1u);
    return b;
}
__device__ __forceinline__ void xcd_barrier_complete(unsigned* bar, unsigned x, unsigned& nloc, unsigned& nx) {
    const unsigned G = gridDim.x * gridDim.y * gridDim.z;
    unsigned sum, cnt, mine, sp = 0u;
    for (;;) {
        sum = 0u; cnt = 0u; mine = 0u;
#pragma unroll
        for (unsigned j = 0; j < 16; ++j) { const unsigned c = xb_ld(&bar[XB_XCNT(j)]); sum += c; cnt += (c > 0u) ? 1u : 0u; mine = (j == x) ? c : mine; }
        if (sum == G) break;
        __builtin_amdgcn_s_sleep(1);
        if ((++sp & 255u) == 0u) { if (xb_ld(&bar[XB_TMO])) break; if (sp > XB_SPIN_CAP) { atomicAdd(&bar[XB_TMO], 1u); break; } }
    }
    nloc = mine > 0u ? mine : 1u; nx = cnt > 0u ? cnt : 1u;
}
__device__ __forceinline__ void xcd_barrier(const XcdBarrier& b) {
    asm volatile("s_waitcnt vmcnt(0)" ::: "memory");
    __syncthreads();
    if (threadIdx.x == 0) {
        unsigned* bar = b.bar;
        __builtin_amdgcn_s_waitcnt(0);
        unsigned nloc = b.st[0], nx = b.st[1];
        if (nloc == 0u) { xcd_barrier_complete(bar, b.x, nloc, nx); b.st[0] = nloc; b.st[1] = nx; }
        const unsigned old = xb_add(&bar[XB_XSUB(b.x)], 1u);
        const unsigned gen = old / nloc;
        if (old + 1u == (gen + 1u) * nloc) {
            __builtin_amdgcn_fence(__ATOMIC_RELEASE, "agent");
            asm volatile("s_waitcnt vmcnt(0)" ::: "memory");
            const unsigned og = xb_add(&bar[XB_TOP], 1u);
            const unsigned tg = og / nx;
            if (og + 1u == (tg + 1u) * nx) xb_add(&bar[XB_TOPGEN], 1u);
            else XB_SPIN(xb_ld(&bar[XB_TOPGEN]) == tg, bar);
            __builtin_amdgcn_fence(__ATOMIC_ACQUIRE, "agent");
            xb_add(&bar[XB_XGEN(b.x)], 1u);
            asm volatile("s_waitcnt vmcnt(0)" ::: "memory");
        } else {
            XB_SPIN(xb_ld(&bar[XB_XGEN(b.x)]) == gen, bar);
            __builtin_amdgcn_fence(__ATOMIC_ACQUIRE, "agent");
            asm volatile("s_waitcnt vmcnt(0)" ::: "memory");
        }
    }
    __syncthreads();
}

struct Args { const float* in[29]; float* out; unsigned char* ws; int ph_lo, ph_hi; };

enum GemmMode { GM_MIX = 0, GM_S1, GM_S3, GM_GLU, GM_GATE, GM_MERGE, GM_WOUT, GM_GU, GM_DOWN };
struct GDesc {
    int mode; const char* A; const char* B; int lda, ldb, K, nM, nN;
    const float* rs_in;
    float* rs_out;
    const float* bias;
    const float* xold; float* xnew; bf16* xb; const bf16* xres;
    unsigned char* ws;
    LAS unsigned char* lds; int rs_pm;
    int eb;
    int blk;
};
struct Unit { const char* A; const char* B; int pm, pn, aux; };

constexpr int BM = 256, BK = 64, HALF = 128, HTB = HALF * BK * 2, NXCD = 8, WGM = 8;
__device__ __forceinline__ int lds_byte(int r, int c) { const int st = (r >> 4) * 2 + (c >> 5), rr = r & 15, cc = c & 31, ob = rr * 64 + cc * 2; return st * 1024 + (ob ^ (((ob >> 9) & 1) << 5)); }
__device__ __forceinline__ void stage_rc(int b, int& R, int& C) { const int st = b / 1024, sb = b % 1024, swz = sb ^ (((sb >> 9) & 1) << 5); R = (st >> 1) * 16 + swz / 64; C = (st & 1) * 32 + (swz % 64) / 2; }
__device__ __forceinline__ int perm32(int rho) { const int n = rho >> 4, i = rho & 15; return 8 * (i >> 2) + 4 * n + (i & 3); }

template <int MODE> __device__ __forceinline__ bool sched_next(const GDesc& d, int G, int c, int i, Unit& u) {
    if (MODE == GM_S1 || MODE == GM_S3) {
        const int L = i * G + c; if (L >= 128) return false;
        const int g = L >> 2, r = L & 3;
        u.A = d.A + (size_t)(g * NCHUNK + r * 256) * d.lda * 2; u.B = d.B + (size_t)g * 256 * d.ldb * 2; u.pm = r; u.pn = 0; u.aux = g; return true;
    }
    int ii = i, sub = 0; if (MODE == GM_MERGE) { ii = i / 3; sub = i - 3 * ii; }
    const int nwg = d.nM * d.nN; const long L = (long)ii * G + c; if (L >= nwg) return false;
    int wgid = (int)L; { const int q = nwg / NXCD, r = nwg % NXCD, xcd = wgid % NXCD, off = wgid / NXCD; wgid = (xcd < r ? xcd * (q + 1) : r * (q + 1) + (xcd - r) * q) + off; }
    const int nig = WGM * d.nN, gid = wgid / nig, fm = gid * WGM, gsz = (d.nM - fm) < WGM ? (d.nM - fm) : WGM;
    u.pm = fm + ((wgid % nig) % gsz); u.pn = (wgid % nig) / gsz; u.aux = sub;
    u.A = d.A + (size_t)u.pm * 256 * d.lda * 2 + sub * 1024; u.B = d.B + (size_t)u.pn * 256 * d.ldb * 2 + sub * 1024; return true;
}

__device__ __forceinline__ void store8(bf16* p, const f32x4& v0, const f32x4& v1) {
    u32x4 w; w.x = cvt_pk_bf16(v0[0], v0[1]); w.y = cvt_pk_bf16(v0[2], v0[3]); w.z = cvt_pk_bf16(v1[0], v1[1]); w.w = cvt_pk_bf16(v1[2], v1[3]); *(GAS u32x4*)p = w;
}
__device__ __forceinline__ void load8(const bf16* p, f32x4& v0, f32x4& v1) {
    const u32x4 w = *(const GAS u32x4*)p; v0 = (f32x4){bf_lo(w.x), bf_hi(w.x), bf_lo(w.y), bf_hi(w.y)}; v1 = (f32x4){bf_lo(w.z), bf_hi(w.z), bf_lo(w.w), bf_hi(w.w)};
}
__device__ __forceinline__ float row_rs(const GAS float* slots, int row) {
    const GAS float* q = (const GAS float*)slots + (size_t)row * 4; const f32x4 v = (*(const GAS f32x4*)q + *(const GAS f32x4*)(q + 4 * M)) + (*(const GAS f32x4*)(q + 8 * M) + *(const GAS f32x4*)(q + 12 * M));
    return __builtin_amdgcn_rsqf(((v[0] + v[1]) + (v[2] + v[3])) * (1.0f / DM) + EPS);
}
__device__ __forceinline__ f32x4 sig4(const f32x4& v) { return (f32x4){fsigmoid(v[0]), fsigmoid(v[1]), fsigmoid(v[2]), fsigmoid(v[3])}; }
__device__ __forceinline__ f32x4 rcp4(const f32x4& v) { return (f32x4){__builtin_amdgcn_rcpf(v[0]), __builtin_amdgcn_rcpf(v[1]), __builtin_amdgcn_rcpf(v[2]), __builtin_amdgcn_rcpf(v[3])}; }
__device__ __forceinline__ f32x4 gelu4(const f32x4& v) { return (f32x4){fgelu(v[0]), fgelu(v[1]), fgelu(v[2]), fgelu(v[3])}; }

template <int MODE> __device__ __forceinline__ bool epilogue(const GDesc& d, const Unit& u, f32x4 (&acc)[2][2][4][2], int wr, int wc, int fr, int fq) {
    asm volatile("" : "+v"(fr), "+v"(fq));
    constexpr int mode = MODE;
    unsigned char* ws = d.ws;
    const int rl0 = wr * 64 + fr;
    const int cl0 = wc * 32 + 8 * fq;
    if constexpr (mode == GM_MIX) {
        const int rowb = u.pm * BM + rl0;
        if (u.pn < 2) {
            bf16* XS = (bf16*)(ws + WS_XS);
#pragma unroll
            for (int ai = 0; ai < 2; ++ai)
#pragma unroll
                for (int m = 0; m < 4; ++m) { const int row = rowb + ai * HALF + m * 16; const float rs = (u.pm == d.rs_pm) ? *(const LAS float*)(d.lds + RST_OFF + (rl0 + ai * HALF + m * 16) * 4) : row_rs((const GAS float*)d.rs_in, row);
#pragma unroll
                    for (int bj = 0; bj < 2; ++bj) { const int ch = u.pn * BM + bj * HALF + cl0; const int g = ch >> 4, p0 = ch & 15;
                        store8(XS + ((size_t)(g * NCHUNK + (row >> 4)) * XSK + (row & 15) * 16 + p0), acc[ai][bj][m][0] * rs, acc[ai][bj][m][1] * rs); } }
        } else if (u.pn < 6) {
            bf16* HC = (bf16*)(ws + WS_HC);
#pragma unroll
            for (int ai = 0; ai < 2; ++ai)
#pragma unroll
                for (int m = 0; m < 4; ++m) { const int row = rowb + ai * HALF + m * 16; const float rs = (u.pm == d.rs_pm) ? *(const LAS float*)(d.lds + RST_OFF + (rl0 + ai * HALF + m * 16) * 4) : row_rs((const GAS float*)d.rs_in, row);
                    store8(HC + (size_t)row * CW + (u.pn - 2) * HALF + cl0, acc[ai][0][m][0] * rs * sig4(acc[ai][1][m][0] * rs), acc[ai][0][m][1] * rs * sig4(acc[ai][1][m][1] * rs)); }
        } else {
            bf16* V = (bf16*)(ws + WS_V);
#pragma unroll
            for (int ai = 0; ai < 2; ++ai)
#pragma unroll
                for (int m = 0; m < 4; ++m) { const int row = rowb + ai * HALF + m * 16; const float rs = (u.pm == d.rs_pm) ? *(const LAS float*)(d.lds + RST_OFF + (rl0 + ai * HALF + m * 16) * 4) : row_rs((const GAS float*)d.rs_in, row);
#pragma unroll
                    for (int bj = 0; bj < 2; ++bj) store8(V + (size_t)row * PW + (u.pn - 6) * BM + bj * HALF + cl0, acc[ai][bj][m][0] * rs, acc[ai][bj][m][1] * rs); }
        }
        return false;
    }
    if constexpr (mode == GM_GATE) {
        GAS bf16* gp = (GAS bf16*)(ws + WS_G) + (size_t)d.blk * (3 * 65536) + (size_t)(u.pn >> 2) * 65536 + ((wr * 4 + wc) * 64 + fq * 16 + fr) * 8;
        const int rowb = u.pm * BM + rl0, colb = u.pn * BM + cl0;
        f32x4 bv[2][2];
#pragma unroll
        for (int bj = 0; bj < 2; ++bj)
#pragma unroll
            for (int n = 0; n < 2; ++n) bv[bj][n] = *(const GAS f32x4*)(d.bias + colb + bj * HALF + 4 * n);
#pragma unroll
        for (int ai = 0; ai < 2; ++ai)
#pragma unroll
            for (int m = 0; m < 4; ++m) { const int row = rowb + ai * HALF + m * 16; const float rs = (u.pm == d.rs_pm) ? *(const LAS float*)(d.lds + RST_OFF + (rl0 + ai * HALF + m * 16) * 4) : row_rs((const GAS float*)d.rs_in, row);
#pragma unroll
                for (int bj = 0; bj < 2; ++bj) store8((bf16*)(gp + ((ai * 4 + m) * 2 + bj) * 4096), sig4(acc[ai][bj][m][0] * rs + bv[bj][0]), sig4(acc[ai][bj][m][1] * rs + bv[bj][1])); }
        return false;
    }
    if constexpr (mode == GM_S3) {
        bf16* YS = (bf16*)(ws + WS_YS);
#pragma unroll
        for (int ai = 0; ai < 2; ++ai)
#pragma unroll
            for (int m = 0; m < 4; ++m) { const int chunk = u.pm * BM + rl0 + ai * HALF + m * 16;
#pragma unroll
                for (int bj = 0; bj < 2; ++bj) { const int col = bj * HALF + cl0; const int tok = chunk * CL + (col >> 4);
                    store8(YS + (size_t)tok * SW + u.aux * NP + (col & 15), gelu4(acc[ai][bj][m][0]), gelu4(acc[ai][bj][m][1])); } }
        return false;
    }
    if constexpr (mode == GM_GLU) {
        const bf16* YS = (const bf16*)(ws + WS_YS); bf16* BR = (bf16*)(ws + WS_BR); const int rowb = u.pm * BM + rl0, colb = u.pn * BM + cl0;
        f32x4 bv[2][2];
#pragma unroll
        for (int bj = 0; bj < 2; ++bj)
#pragma unroll
            for (int n = 0; n < 2; ++n) bv[bj][n] = *(const GAS f32x4*)(d.bias + colb + bj * HALF + 4 * n);
#pragma unroll
        for (int ai = 0; ai < 2; ++ai) {
            u32x4 yw[4][2];
#pragma unroll
            for (int m = 0; m < 4; ++m)
#pragma unroll
                for (int bj = 0; bj < 2; ++bj) yw[m][bj] = *(const GAS u32x4*)(YS + (size_t)(rowb + ai * HALF + m * 16) * SW + colb + bj * HALF);
#pragma unroll
            for (int m = 0; m < 4; ++m) { const int row = rowb + ai * HALF + m * 16;
#pragma unroll
                for (int bj = 0; bj < 2; ++bj) { const u32x4 w = yw[m][bj];
                    const f32x4 y0 = (f32x4){bf_lo(w.x), bf_hi(w.x), bf_lo(w.y), bf_hi(w.y)}, y1 = (f32x4){bf_lo(w.z), bf_hi(w.z), bf_lo(w.w), bf_hi(w.w)};
                    store8(BR + (size_t)row * 1536 + colb + bj * HALF, y0 * sig4(acc[ai][bj][m][0] + bv[bj][0]), y1 * sig4(acc[ai][bj][m][1] + bv[bj][1])); } }
        }
        return false;
    }
    if constexpr (mode == GM_MERGE) {
        const GAS bf16* gp = (const GAS bf16*)(ws + WS_G) + (size_t)d.blk * (3 * 65536) + ((wr * 4 + wc) * 64 + fq * 16 + fr) * 8;
        bf16* MG = d.xb; const int rowb = u.pm * BM + rl0, colb = u.pn * BM + cl0, sub = u.aux;
#pragma unroll
        for (int ai = 0; ai < 2; ++ai)
#pragma unroll
        for (int mh = 0; mh < 2; ++mh) {
            u32x4 ga[2][2], gb[2][2];
#pragma unroll
            for (int m2 = 0; m2 < 2; ++m2)
#pragma unroll
                for (int bj = 0; bj < 2; ++bj) { const GAS bf16* p = gp + (size_t)sub * 65536 + ((ai * 4 + mh * 2 + m2) * 2 + bj) * 4096;
                    ga[m2][bj] = *(const GAS u32x4*)p; gb[m2][bj] = (sub < 2) ? *(const GAS u32x4*)(p + 65536) : ga[m2][bj]; }
#pragma unroll
            for (int m2 = 0; m2 < 2; ++m2) { const int m = mh * 2 + m2, row = rowb + ai * HALF + m * 16;
#pragma unroll
                for (int bj = 0; bj < 2; ++bj) { const u32x4 wa = ga[m2][bj], wb = gb[m2][bj];
                    const f32x4 a0 = (f32x4){bf_lo(wa.x), bf_hi(wa.x), bf_lo(wa.y), bf_hi(wa.y)}, a1 = (f32x4){bf_lo(wa.z), bf_hi(wa.z), bf_lo(wa.w), bf_hi(wa.w)};
                    if (sub < 2) { const f32x4 b0 = (f32x4){bf_lo(wb.x), bf_hi(wb.x), bf_lo(wb.y), bf_hi(wb.y)}, b1 = (f32x4){bf_lo(wb.z), bf_hi(wb.z), bf_lo(wb.w), bf_hi(wb.w)};
                        acc[ai][bj][m][0] *= a0 * rcp4(b0); acc[ai][bj][m][1] *= a1 * rcp4(b1); }
                    else store8(MG + (size_t)row * DM + colb + bj * HALF, acc[ai][bj][m][0] * a0, acc[ai][bj][m][1] * a1); } }
        }
        return sub < 2;
    }
    if constexpr (mode == GM_WOUT || mode == GM_DOWN) {
        const int rowb = u.pm * BM + rl0, colb = u.pn * BM + cl0; const bool res16 = (d.xold == nullptr), st32 = (d.xnew != nullptr);
#pragma unroll
        for (int ai = 0; ai < 2; ++ai)
#pragma unroll
        for (int mh = 0; mh < 2; ++mh) {
            f32x4 xo[2][2][2];
#pragma unroll
            for (int m2 = 0; m2 < 2; ++m2)
#pragma unroll
                for (int bj = 0; bj < 2; ++bj) { const size_t o = (size_t)(rowb + ai * HALF + (mh * 2 + m2) * 16) * DM + colb + bj * HALF;
                    if (res16) load8(d.xres + o, xo[m2][bj][0], xo[m2][bj][1]);
                    else { const GAS float* p = (const GAS float*)d.xold + o; xo[m2][bj][0] = *(const GAS f32x4*)p; xo[m2][bj][1] = *(const GAS f32x4*)(p + 4); } }
#pragma unroll
            for (int m2 = 0; m2 < 2; ++m2) { const int m = mh * 2 + m2; const int row = rowb + ai * HALF + m * 16; float ss = 0.f;
#pragma unroll
                for (int bj = 0; bj < 2; ++bj) { const size_t o = (size_t)row * DM + colb + bj * HALF;
                    const f32x4 x0 = xo[m2][bj][0] + acc[ai][bj][m][0], x1 = xo[m2][bj][1] + acc[ai][bj][m][1];
                    if (st32) { *(GAS f32x4*)(d.xnew + o) = x0; *(GAS f32x4*)(d.xnew + o + 4) = x1; }
                    store8(d.xb + o, x0, x1);
                    ss += (x0[0] * x0[0] + x0[1] * x0[1]) + (x0[2] * x0[2] + x0[3] * x0[3]) + (x1[0] * x1[0] + x1[1] * x1[1]) + (x1[2] * x1[2] + x1[3] * x1[3]); }
                ss += __shfl_xor(ss, 16); ss += __shfl_xor(ss, 32);
                if (fq == 0) *((GAS float*)d.rs_out + (size_t)u.pn * (4 * M) + (size_t)row * 4 + wc) = ss; }
        }
        return false;
    }
    if constexpr (mode == GM_GU) {
        bf16* HID = (bf16*)(ws + WS_HID); const int rowb = u.pm * BM + rl0;
#pragma unroll
        for (int ai = 0; ai < 2; ++ai)
#pragma unroll
            for (int m = 0; m < 4; ++m) { const int row = rowb + ai * HALF + m * 16; const float rs = (u.pm == d.rs_pm) ? *(const LAS float*)(d.lds + RST_OFF + (rl0 + ai * HALF + m * 16) * 4) : row_rs((const GAS float*)d.rs_in, row);
                const f32x4 g0 = acc[ai][0][m][0] * rs, g1 = acc[ai][0][m][1] * rs;
                store8(HID + (size_t)row * FF + u.pn * HALF + cl0, g0 * sig4(g0) * (acc[ai][1][m][0] * rs), g1 * sig4(g1) * (acc[ai][1][m][1] * rs)); }
        return false;
    }
}

template <int MODE> __device__ __forceinline__ void gemm_phase(LAS unsigned char* lds, const GDesc& g, int G, int c, int wave_id) {
    int lane = (int)__builtin_amdgcn_mbcnt_hi(~0u, __builtin_amdgcn_mbcnt_lo(~0u, 0u)); asm volatile("" : "+v"(lane));
    const int wid = wave_id, tid = wid * 64 + lane, wr = wid >> 2, wc = wid & 3, fr = lane & 15, fq = lane >> 4;
    const int K = g.K, nt = K / BK;
    unsigned voffA[2], voffB[2];
#pragma unroll
    for (int i = 0; i < 2; ++i) { int R, C; stage_rc(tid * 16 + i * 8192, R, C); const int Rb = (R & ~31) + perm32(R & 31);
        voffA[i] = (unsigned)(R * g.lda + C) * 2u; voffB[i] = (unsigned)(Rb * g.ldb + C) * 2u; }
    const size_t kstep = (size_t)(BK * 2);
    const size_t hstepA = (size_t)HALF * g.lda * 2, hstepB = (size_t)HALF * g.ldb * 2;
    const unsigned ldsw = (unsigned)wid * 1024u;
    const int aoff = lds_byte(wr * 64 + fr, fq * 8), boff = lds_byte(wc * 32 + fr, fq * 8);
#define PG8_SA(b, h) (((b) * 2 + (h)) * HTB)
#define PG8_SB(b, h) ((4 + (b) * 2 + (h)) * HTB)
#define PG8_STAGE(bufoff, gbase, voff) do { _Pragma("unroll") for (int _i = 0; _i < 2; ++_i) \
        __builtin_amdgcn_global_load_lds((const unsigned*)((const char*)(gbase) + (voff)[_i]), (LAS unsigned*)(lds + (bufoff) + ldsw + _i * 8192), 16, 0, 0); } while (0)
#define PG8_LDA(dst, b, h) do { _Pragma("unroll") for (int m = 0; m < 4; ++m) _Pragma("unroll") for (int k = 0; k < 2; ++k) dst[m][k] = *(const LAS bf16x8*)(lds + PG8_SA(b, h) + aoff + m * 2048 + k * 1024); } while (0)
#define PG8_LDB(dst, b, h) do { _Pragma("unroll") for (int n = 0; n < 2; ++n) _Pragma("unroll") for (int k = 0; k < 2; ++k) dst[n][k] = *(const LAS bf16x8*)(lds + PG8_SB(b, h) + boff + n * 2048 + k * 1024); } while (0)
#define PG8_MMA(ai, bj, At, Bt) do { __builtin_amdgcn_s_setprio(1); _Pragma("unroll") for (int m = 0; m < 4; ++m) _Pragma("unroll") for (int n = 0; n < 2; ++n) _Pragma("unroll") for (int k = 0; k < 2; ++k) \
        acc[ai][bj][m][n] = __builtin_amdgcn_mfma_f32_16x16x32_bf16(Bt[n][k], At[m][k], acc[ai][bj][m][n], 0, 0, 0); __builtin_amdgcn_s_setprio(0); } while (0)
#define PG8_WAIT_V(n) asm volatile("s_waitcnt vmcnt(" #n ")" ::: "memory")
#define PG8_WAIT_L(n) asm volatile("s_waitcnt lgkmcnt(" #n ")" ::: "memory")
#define PG8_BAR __builtin_amdgcn_s_barrier()
#define PG8_SCHED __builtin_amdgcn_sched_barrier(0)
    Unit cur, nxt; int ui = 0;
    if (!sched_next<MODE>(g, G, c, 0, cur)) return;
    GDesc gd = g; gd.lds = lds; gd.rs_pm = -1;
    if constexpr (MODE == GM_MIX || MODE == GM_GATE || MODE == GM_GU) {
        if (tid < 256) *(LAS float*)(lds + RST_OFF + tid * 4) = row_rs((const GAS float*)g.rs_in, cur.pm * BM + tid);
        gd.rs_pm = cur.pm;
        asm volatile("s_waitcnt vmcnt(0) lgkmcnt(0)" ::: "memory"); __builtin_amdgcn_s_barrier(); asm volatile("" ::: "memory");
    }
    f32x4 acc[2][2][4][2];
#pragma unroll
    for (int a = 0; a < 2; ++a)
#pragma unroll
        for (int b = 0; b < 2; ++b)
#pragma unroll
            for (int m = 0; m < 4; ++m)
#pragma unroll
                for (int n = 0; n < 2; ++n) acc[a][b][m][n] = (f32x4){0.f, 0.f, 0.f, 0.f};
    bf16x8 At[4][2], B0[2][2], B1[2][2];
    const char* cA = cur.A; const char* cB = cur.B;
#if MK_SP2
    PG8_STAGE(PG8_SB(0, 0), cB, voffB); PG8_STAGE(PG8_SB(0, 1), cB + hstepB, voffB); PG8_STAGE(PG8_SA(0, 0), cA, voffA); PG8_STAGE(PG8_SA(0, 1), cA + hstepA, voffA);
    if (wr == 1) PG8_BAR;
    PG8_WAIT_V(2); PG8_BAR;
    PG8_STAGE(PG8_SB(1, 0), cB + kstep, voffB); PG8_STAGE(PG8_SA(1, 0), cA + kstep, voffA); PG8_STAGE(PG8_SB(1, 1), cB + hstepB + kstep, voffB);
    PG8_WAIT_V(6); PG8_BAR;
#else
    PG8_STAGE(PG8_SB(0, 0), cB, voffB); PG8_STAGE(PG8_SA(0, 0), cA, voffA); PG8_STAGE(PG8_SB(0, 1), cB + hstepB, voffB); PG8_STAGE(PG8_SA(0, 1), cA + hstepA, voffA);
    if (wr == 1) PG8_BAR;
    PG8_WAIT_V(4); PG8_BAR;
    PG8_STAGE(PG8_SB(1, 0), cB + kstep, voffB); PG8_STAGE(PG8_SA(1, 0), cA + kstep, voffA); PG8_STAGE(PG8_SB(1, 1), cB + hstepB + kstep, voffB);
    PG8_WAIT_V(6); PG8_BAR;
#endif
    for (;;) {
        const bool has_next = sched_next<MODE>(g, G, c, ui + 1, nxt);
        const char* nA = has_next ? nxt.A : cA; const char* nB = has_next ? nxt.B : cB;
        for (int t = 0; t < nt; t += 2) {
            const bool last = (t == nt - 2);
            const char* a1 = cA + (size_t)(t + 1) * kstep;
            const char* a2 = last ? nA : cA + (size_t)(t + 2) * kstep; const char* b2 = last ? nB : cB + (size_t)(t + 2) * kstep;
            const char* a3 = a2 + kstep; const char* b3 = b2 + kstep;
#if MK_SP2
            PG8_LDB(B0, 0, 0); PG8_LDB(B1, 0, 1); PG8_SCHED; PG8_LDA(At, 0, 0); PG8_STAGE(PG8_SA(1, 1), a1 + hstepA, voffA);
            PG8_WAIT_V(8); PG8_WAIT_L(0); PG8_BAR; PG8_MMA(0, 0, At, B0); PG8_MMA(0, 1, At, B1); PG8_BAR; PG8_SCHED;
            PG8_LDA(At, 0, 1); PG8_STAGE(PG8_SB(0, 0), b2, voffB); PG8_STAGE(PG8_SB(0, 1), b2 + hstepB, voffB); PG8_STAGE(PG8_SA(0, 0), a2, voffA);
            PG8_WAIT_V(8); PG8_WAIT_L(0); PG8_BAR; PG8_MMA(1, 0, At, B0); PG8_MMA(1, 1, At, B1); PG8_BAR; PG8_SCHED;
            PG8_LDB(B0, 1, 0); PG8_LDB(B1, 1, 1); PG8_SCHED; PG8_LDA(At, 1, 0); PG8_STAGE(PG8_SA(0, 1), a2 + hstepA, voffA);
            PG8_WAIT_V(8); PG8_WAIT_L(0); PG8_BAR; PG8_MMA(0, 0, At, B0); PG8_MMA(0, 1, At, B1); PG8_BAR; PG8_SCHED;
            PG8_LDA(At, 1, 1); PG8_STAGE(PG8_SB(1, 0), b3, voffB); PG8_STAGE(PG8_SB(1, 1), b3 + hstepB, voffB); PG8_STAGE(PG8_SA(1, 0), a3, voffA);
            PG8_WAIT_V(8); PG8_WAIT_L(0); PG8_BAR; PG8_MMA(1, 0, At, B0); PG8_MMA(1, 1, At, B1); PG8_BAR; PG8_SCHED;
#else
            PG8_LDB(B0, 0, 0); PG8_SCHED; PG8_LDA(At, 0, 0); PG8_STAGE(PG8_SA(1, 1), a1 + hstepA, voffA);
            PG8_WAIT_L(8); PG8_BAR; PG8_WAIT_L(0); PG8_MMA(0, 0, At, B0); PG8_BAR; PG8_SCHED;
            PG8_LDB(B1, 0, 1); PG8_STAGE(PG8_SB(0, 0), b2, voffB);
            PG8_BAR; PG8_WAIT_L(0); PG8_MMA(0, 1, At, B1); PG8_BAR;
            PG8_LDA(At, 0, 1); PG8_STAGE(PG8_SA(0, 0), a2, voffA);
            PG8_BAR; PG8_WAIT_L(0); PG8_MMA(1, 0, At, B0); PG8_BAR; PG8_SCHED;
            PG8_STAGE(PG8_SB(0, 1), b2 + hstepB, voffB);
            PG8_WAIT_V(6); PG8_BAR; PG8_MMA(1, 1, At, B1); PG8_BAR;
            PG8_LDB(B0, 1, 0); PG8_SCHED; PG8_LDA(At, 1, 0); PG8_STAGE(PG8_SA(0, 1), a2 + hstepA, voffA);
            PG8_WAIT_L(8); PG8_BAR; PG8_WAIT_L(0); PG8_MMA(0, 0, At, B0); PG8_BAR; PG8_SCHED;
            PG8_LDB(B1, 1, 1); PG8_STAGE(PG8_SB(1, 0), b3, voffB);
            PG8_BAR; PG8_WAIT_L(0); PG8_MMA(0, 1, At, B1); PG8_BAR;
            PG8_LDA(At, 1, 1); PG8_STAGE(PG8_SA(1, 0), a3, voffA);
            PG8_BAR; PG8_WAIT_L(0); PG8_MMA(1, 0, At, B0); PG8_BAR; PG8_SCHED;
            PG8_STAGE(PG8_SB(1, 1), b3 + hstepB, voffB);
            PG8_WAIT_V(6); PG8_BAR; PG8_MMA(1, 1, At, B1); PG8_BAR;
#endif
        }
        if (wr == 0) PG8_BAR;
        bool keep = false;
        if constexpr (MODE == GM_S1) break;
        else keep = epilogue<MODE>(gd, cur, acc, wr, wc, fr, fq);
        if (!has_next) break;
        if (!keep) {
#pragma unroll
            for (int a = 0; a < 2; ++a)
#pragma unroll
                for (int b = 0; b < 2; ++b)
#pragma unroll
                    for (int m = 0; m < 4; ++m)
#pragma unroll
                        for (int n = 0; n < 2; ++n) acc[a][b][m][n] = (f32x4){0.f, 0.f, 0.f, 0.f};
        }
        cur = nxt; cA = nA; cB = nB; ++ui;
        if (wr == 1) PG8_BAR;
    }
    PG8_WAIT_V(0);
    PG8_BAR; asm volatile("" ::: "memory");
    if constexpr (MODE == GM_S1) {
        LAS float* SL = (LAS float*)lds;
#pragma unroll
        for (int ai = 0; ai < 2; ++ai)
#pragma unroll
            for (int m = 0; m < 4; ++m) { LAS float* p = SL + (ai * HALF + wr * 64 + m * 16 + fr) * 128 + wc * 32 + 8 * fq; *(LAS f32x4*)p = acc[ai][0][m][0]; *(LAS f32x4*)(p + 4) = acc[ai][0][m][1]; }
        PG8_WAIT_L(0); PG8_BAR; asm volatile("" ::: "memory");
        if (tid < 128) {
            const int bb = tid >> 6, n = tid & 63, grp = cur.aux, b = 2 * cur.pm + bb;
            const GAS float* LAM = (const GAS float*)(g.ws + ws_lam(g.eb)) + (size_t)grp * 128; const float lr = LAM[2 * n], li = LAM[2 * n + 1];
            GAS bf16* XT = (GAS bf16*)(g.ws + WS_XS) + (size_t)(grp * NCHUNK + b * CPB) * XSK + 256 + n;
            const LAS float* Sp = SL + (bb * 128) * 128 + n;
            float hr = 0.f, hi = 0.f;
            for (int c0 = 0; c0 < CPB; c0 += 8) {
                float sr[8], si[8];
#pragma unroll
                for (int e = 0; e < 8; ++e) { sr[e] = Sp[(c0 + e) * 128]; si[e] = Sp[(c0 + e) * 128 + 64]; }
#pragma unroll
                for (int e = 0; e < 8; ++e) { XT[(size_t)(c0 + e) * XSK] = (bf16)f2bf(hr); XT[(size_t)(c0 + e) * XSK + 64] = (bf16)f2bf(hi);
                    const float nr = lr * hr - li * hi + sr[e], ni = lr * hi + li * hr + si[e]; hr = nr; hi = ni; }
            }
        }
        asm volatile("" ::: "memory"); PG8_BAR; asm volatile("" ::: "memory");
    }
#undef PG8_SA
#undef PG8_SB
#undef PG8_STAGE
#undef PG8_LDA
#undef PG8_LDB
#undef PG8_MMA
#undef PG8_WAIT_V
#undef PG8_WAIT_L
#undef PG8_BAR
#undef PG8_SCHED
}

typedef const GAS float* const __attribute__((address_space(4))) * KargPtr;
struct InTab { KargPtr kp; __device__ __forceinline__ const GAS float* operator[](int i) const { return (const GAS float*)kp[i]; } };
#define ARG_IN(i) (F.in[(i)])
struct Frame { LAS unsigned char* lds; int tid, lane, wave, vcu, G; InTab in; GAS float* out; GAS unsigned char* ws; };

constexpr int CW_DEP = 12288;
constexpr int CW_QUEUE = 8192;
static_assert((CW_DEP + 64 * 4 * DEPTH) * 4 <= (int)CTL_ZERO_BYTES && (CW_QUEUE + 64 * (1 + 2 * DEPTH)) <= CW_DEP && CW_BAR + XCD_BAR_WORDS <= CW_QUEUE, "control words inside the per-call memset");
__device__ __forceinline__ int queue_pull(Frame& F, int k) {
    volatile LAS int* slot = (volatile LAS int*)(F.lds + MISC_OFF + 64);
    __syncthreads();
    if (F.tid == 0) *slot = (int)__hip_atomic_fetch_add((unsigned*)(F.ws + WS_CTL) + CW_QUEUE + 64 * k, 1u, RLX_AGENT);
    __syncthreads();
    return *slot;
}
__device__ __forceinline__ float wave_sum(float v) {
#pragma unroll
    for (int o = 1; o < 64; o <<= 1) v += __shfl_xor(v, o);
    return v;
}
struct TItem { const GAS float* W; int ldw, col0, k0; const GAS float* gain; GAS bf16* dst; int ldd; };
__device__ __forceinline__ void titem_load(const TItem& t, f32x4 (&v)[8], int lane) {
    const int c4 = (lane & 7) * 4;
#pragma unroll
    for (int i = 0; i < 8; ++i) { const int kk = 8 * i + (lane >> 3); v[i] = *(const GAS f32x4*)(t.W + (size_t)(t.k0 + kk) * t.ldw + t.col0 + c4); }
}
__device__ __forceinline__ void titem_finish(const TItem& t, const f32x4 (&v)[8], LAS float* scr, int lane) {
    const int c4 = (lane & 7) * 4;
#pragma unroll
    for (int i = 0; i < 8; ++i) { const int kk = 8 * i + (lane >> 3); const float gn = t.gain ? t.gain[t.k0 + kk] : 1.0f; LAS float* p = scr + kk * 33 + c4;
        p[0] = v[i][0] * gn; p[1] = v[i][1] * gn; p[2] = v[i][2] * gn; p[3] = v[i][3] * gn; }
    LDS_WAIT(); asm volatile("" ::: "memory");
    const int c = lane & 7;
#pragma unroll
    for (int j = 0; j < 4; ++j) { const int n = (lane >> 3) + 8 * j; const LAS float* s = scr + (8 * c) * 33 + n;
        u32x4 o; o.x = pk2(s[0 * 33], s[1 * 33]); o.y = pk2(s[2 * 33], s[3 * 33]); o.z = pk2(s[4 * 33], s[5 * 33]); o.w = pk2(s[6 * 33], s[7 * 33]);
        *(GAS u32x4*)(t.dst + (size_t)n * t.ldd + t.k0 + 8 * c) = o; }
    LDS_WAIT(); asm volatile("" ::: "memory");
}
__device__ __forceinline__ void transpose_item(const GAS float* W, int ldw, int col0, int k0, const GAS float* gain, GAS bf16* dst, int ldd, LAS float* scr, int lane) {
    const TItem t{W, ldw, col0, k0, gain, dst, ldd}; f32x4 v[8]; titem_load(t, v, lane); titem_finish(t, v, scr, lane);
}

#if MK_PROBE
#define S5STAMP(k) do { if (blockIdx.x == 0 && threadIdx.x == 0 && l == 0) ((volatile LAS unsigned long long*)(F.lds + 132096))[k] = __builtin_amdgcn_s_memrealtime(); } while (0)
#else
#define S5STAMP(k) do {} while (0)
#endif
__device__ __forceinline__ void s5_group_prep(Frame& F, int l, int g) {
    LAS float* LPr = (LAS float*)F.lds;
    LAS float* LPi = LPr + 17 * 64;
    LAS float* BBr = LPi + 17 * 64;
    LAS float* BBi = BBr + 1024;
    LAS float* Cr = BBi + 1024;
    LAS float* Ci = Cr + 1024;
    LAS float* Kt = Ci + 1024;
    LAS float* Dk = Kt + 4096;
    const GAS float* a_re = F.in[4] + (size_t)(l * NG + g) * NS; const GAS float* a_im = F.in[5] + (size_t)(l * NG + g) * NS; const float log_dt = F.in[6][l * NG + g];
    const GAS float* b_re = F.in[7] + (size_t)(l * NG + g) * NS * NP; const GAS float* b_im = F.in[8] + (size_t)(l * NG + g) * NS * NP;
    const GAS float* c_re = F.in[9] + (size_t)(l * NG + g) * NP * NS; const GAS float* c_im = F.in[10] + (size_t)(l * NG + g) * NP * NS; const GAS float* dsk = F.in[11] + (size_t)(l * NG + g) * NP;
    const double dt = exp((double)log_dt);
    for (int idx = F.tid; idx < 17 * 64; idx += NTHR) { const int tau = idx >> 6, n = idx & 63;
        const double mag = exp((double)tau * dt * (double)a_re[n]), ang = (double)tau * dt * (double)a_im[n];
        const double angr = ang - 6.283185307179586476925 * rint(ang * 0.15915494309189533577);
        LPr[idx] = (float)(mag * (double)cosf((float)angr)); LPi[idx] = (float)(mag * (double)sinf((float)angr)); }
    for (int idx = F.tid; idx < 1024; idx += NTHR) { const int n = idx >> 4;
        const double ar = a_re[n], ai = a_im[n], mag = exp(dt * ar), ang = dt * ai, angr = ang - 6.283185307179586476925 * rint(ang * 0.15915494309189533577);
        const double abr = mag * (double)cosf((float)angr), abi = mag * (double)sinf((float)angr), den = ar * ar + ai * ai, nr = abr - 1.0, ni = abi;
        const double fr = (nr * ar + ni * ai) / den, fi = (ni * ar - nr * ai) / den, br = b_re[idx], bi = b_im[idx];
        BBr[idx] = (float)(fr * br - fi * bi); BBi[idx] = (float)(fr * bi + fi * br);
        Cr[idx] = c_re[idx]; Ci[idx] = c_im[idx]; }
    if (F.tid < 16) Dk[F.tid] = dsk[F.tid];
    __syncthreads();
    { const int tau = F.tid >> 5, q = (F.tid >> 1) & 15, p0 = (F.tid & 1) * 8; float kr[8];
#pragma unroll
      for (int e = 0; e < 8; ++e) kr[e] = 0.f;
#pragma unroll 4
      for (int n = 0; n < 64; ++n) { const float cr = Cr[q * 64 + n], ci = Ci[q * 64 + n], lr = LPr[tau * 64 + n], li = LPi[tau * 64 + n], xr = cr * lr - ci * li, xi = cr * li + ci * lr;
          const f32x4 br0 = *(const LAS f32x4*)(BBr + n * 16 + p0), br1 = *(const LAS f32x4*)(BBr + n * 16 + p0 + 4), bi0 = *(const LAS f32x4*)(BBi + n * 16 + p0), bi1 = *(const LAS f32x4*)(BBi + n * 16 + p0 + 4);
#pragma unroll
          for (int e = 0; e < 4; ++e) { kr[e] += xr * br0[e] - xi * bi0[e]; kr[4 + e] += xr * br1[e] - xi * bi1[e]; } }
#pragma unroll
      for (int e = 0; e < 8; ++e) Kt[(tau * 16 + q) * 16 + p0 + e] = kr[e]; }
    __syncthreads();
    const int eb = l & 1;
    GAS bf16* TW = (GAS bf16*)(F.ws + ws_e(eb) + EO_TW) + (size_t)g * 256 * XSK;
    for (int pc = F.tid; pc < 256 * 32; pc += NTHR) { const int row = pc >> 5, k8 = (pc & 31) * 8, i = row >> 4, q = row & 15, j = k8 >> 4, p0 = k8 & 15;
        const int tau = (i - j) > 0 ? (i - j) : 0; const LAS float* kp = Kt + (tau * 16 + q) * 16 + p0;
        f32x4 v0 = *(const LAS f32x4*)kp, v1 = *(const LAS f32x4*)(kp + 4);
        const float dq = Dk[q]; const int dpos = (i == j) ? q - p0 : -1;
#pragma unroll
        for (int e = 0; e < 4; ++e) { v0[e] = (j <= i) ? v0[e] + (dpos == e ? dq : 0.f) : 0.f; v1[e] = (j <= i) ? v1[e] + (dpos == 4 + e ? dq : 0.f) : 0.f; }
        u32x4 o; o.x = pk2(v0[0], v0[1]); o.y = pk2(v0[2], v0[3]); o.z = pk2(v1[0], v1[1]); o.w = pk2(v1[2], v1[3]);
        *(GAS u32x4*)(TW + (size_t)row * XSK + k8) = o; }
    for (int pc = F.tid; pc < 256 * 16; pc += NTHR) { const int row = pc >> 4, kk = (pc & 15) * 8, i = row >> 4, q = row & 15, part = kk >> 6, n0 = kk & 63;
        const f32x4 cr0 = *(const LAS f32x4*)(Cr + q * 64 + n0), cr1 = *(const LAS f32x4*)(Cr + q * 64 + n0 + 4), ci0 = *(const LAS f32x4*)(Ci + q * 64 + n0), ci1 = *(const LAS f32x4*)(Ci + q * 64 + n0 + 4);
        const f32x4 lr0 = *(const LAS f32x4*)(LPr + (i + 1) * 64 + n0), lr1 = *(const LAS f32x4*)(LPr + (i + 1) * 64 + n0 + 4), li0 = *(const LAS f32x4*)(LPi + (i + 1) * 64 + n0), li1 = *(const LAS f32x4*)(LPi + (i + 1) * 64 + n0 + 4);
        const f32x4 v0 = part == 0 ? (cr0 * lr0 - ci0 * li0) : -(cr0 * li0 + ci0 * lr0), v1 = part == 0 ? (cr1 * lr1 - ci1 * li1) : -(cr1 * li1 + ci1 * lr1);
        u32x4 o; o.x = pk2(v0[0], v0[1]); o.y = pk2(v0[2], v0[3]); o.z = pk2(v1[0], v1[1]); o.w = pk2(v1[2], v1[3]);
        *(GAS u32x4*)(TW + (size_t)row * XSK + 256 + kk) = o; }
    GAS bf16* WS = (GAS bf16*)(F.ws + ws_e(eb) + EO_WS) + (size_t)g * 256 * 256;
    for (int pc = F.tid; pc < 256 * 32; pc += NTHR) { const int row = pc >> 5, k8 = (pc & 31) * 8, j = k8 >> 4, p0 = k8 & 15, n = row & 63;
        const float lr = LPr[(15 - j) * 64 + n], li = LPi[(15 - j) * 64 + n];
        const f32x4 br0 = *(const LAS f32x4*)(BBr + n * 16 + p0), br1 = *(const LAS f32x4*)(BBr + n * 16 + p0 + 4), bi0 = *(const LAS f32x4*)(BBi + n * 16 + p0), bi1 = *(const LAS f32x4*)(BBi + n * 16 + p0 + 4);
        f32x4 v0 = row < 64 ? (br0 * lr - bi0 * li) : (bi0 * lr + br0 * li), v1 = row < 64 ? (br1 * lr - bi1 * li) : (bi1 * lr + br1 * li);
        if (row >= 128) { v0 = (f32x4){0.f, 0.f, 0.f, 0.f}; v1 = v0; }
        u32x4 o; o.x = pk2(v0[0], v0[1]); o.y = pk2(v0[2], v0[3]); o.z = pk2(v1[0], v1[1]); o.w = pk2(v1[2], v1[3]);
        *(GAS u32x4*)(WS + (size_t)row * 256 + k8) = o; }
    GAS float* LAM = (GAS float*)(F.ws + ws_lam(eb)) + (size_t)g * 128;
    if (F.tid < 64) { LAM[F.tid * 2] = LPr[16 * 64 + F.tid]; LAM[F.tid * 2 + 1] = LPi[16 * 64 + F.tid]; }
    __syncthreads();
}

__device__ __forceinline__ void pool_fold_item(Frame& F, int l, int item) {
    const int kk = item >> 4, k0 = (item & 15) * 64;
    LAS float* Wi = (LAS float*)F.lds;
    LAS float* Wg = Wi + 64 * 129;
    LAS bf16* To = (LAS bf16*)(Wg + 128 * 128);
    const GAS float* w_in = F.in[2] + (size_t)l * DM * INW; const GAS float* wgrp = F.in[20] + (size_t)(l * 4 + kk) * PGW * PGW; const GAS float* norm1 = F.in[1] + (size_t)l * DM;
    {
        f32x4 wi[4], wg[8];
#pragma unroll
        for (int j = 0; j < 4; ++j) { const int i4 = F.tid + j * NTHR, r = i4 >> 5, c4 = (i4 & 31) * 4; wi[j] = *(const GAS f32x4*)(w_in + (size_t)(k0 + r) * INW + 1536 + kk * PGW + c4); }
#pragma unroll
        for (int j = 0; j < 8; ++j) wg[j] = *(const GAS f32x4*)(wgrp + (size_t)(F.tid + j * NTHR) * 4);
#pragma unroll
        for (int j = 0; j < 4; ++j) { const int i4 = F.tid + j * NTHR, r = i4 >> 5, c4 = (i4 & 31) * 4; LAS float* p = Wi + r * 129 + c4; p[0] = wi[j][0]; p[1] = wi[j][1]; p[2] = wi[j][2]; p[3] = wi[j][3]; }
#pragma unroll
        for (int j = 0; j < 8; ++j) *(LAS f32x4*)(Wg + (F.tid + j * NTHR) * 4) = wg[j];
    }
    __syncthreads();
    const int k = F.tid >> 3, jg = F.tid & 7; float acc[16];
#pragma unroll
    for (int e = 0; e < 16; ++e) acc[e] = 0.f;
    for (int i = 0; i < 128; ++i) { const float a = Wi[k * 129 + i];
#pragma unroll
        for (int e = 0; e < 16; ++e) acc[e] += a * Wg[i * 128 + jg * 16 + e]; }
    const float gn = norm1[k0 + k];
#pragma unroll
    for (int e = 0; e < 16; ++e) To[(jg * 16 + e) * 72 + k] = (bf16)f2bf(acc[e] * gn);
    __syncthreads();
    GAS bf16* dst = (GAS bf16*)(F.ws + ws_e(l & 1) + EO_WMIX) + (size_t)(1536 + kk * PGW) * DM + k0;
    for (int pc = F.tid; pc < 128 * 8; pc += NTHR) { const int j = pc >> 3, c8 = (pc & 7) * 8; *(GAS u32x4*)(dst + (size_t)j * DM + c8) = *(const LAS u32x4*)(To + j * 72 + c8); }
    __syncthreads();
}

__device__ __forceinline__ void convert_E_waves(Frame& F, int l, int w, int NW, int it_lo, int it_hi) {
    const InTab in = F.in; const int eb = l & 1;
    LAS float* scr = (LAS float*)(F.lds + F.wave * 16384);
    const GAS float* norm1 = in[1] + (size_t)l * DM; const GAS float* w_in = in[2] + (size_t)l * DM * INW;
    constexpr int R1 = 768, R2 = R1 + 128, R3 = R2 + 16;
    if (it_hi > R3) it_hi = R3;
    for (int it = it_lo + w; it < it_hi; it += NW) {
        if (it < R1) {
            const int blk = it >> 6, r = it & 63, kb = r >> 2, nb = r & 3;
            int col0; if (blk < 4) col0 = blk * 128; else { const int t = (blk - 4) >> 1, gt = (blk - 4) & 1; col0 = 512 + gt * 512 + t * 128; }
            transpose_item(w_in, INW, col0 + nb * 32, kb * 64, norm1, (GAS bf16*)(F.ws + ws_e(eb) + EO_WMIX) + (size_t)(blk * 128 + nb * 32) * DM, DM, scr, F.lane);
        } else if (it < R2) { const int r = it - R1, blk = r >> 5, q = r & 31, kb = q >> 2, nb = q & 3;
            transpose_item(in[12] + (size_t)l * SW * SW, SW, blk * 128 + nb * 32, kb * 64, nullptr, (GAS bf16*)(F.ws + ws_e(eb) + EO_WGLU) + (size_t)(blk * 128 + nb * 32) * SW, SW, scr, F.lane);
        } else {
            const GAS float* wdw = in[15] + (size_t)l * CKW * CW; GAS float* cwt = (GAS float*)(F.ws + ws_cwt(eb));
            for (int j = F.lane; j < 1024; j += 64) { const int i = (it - R2) * 1024 + j, cpair = i >> 6, k = (i >> 1) & 31, e = i & 1; cwt[i] = (k < CKW) ? wdw[k * CW + 2 * cpair + e] : 0.f; }
        }
    }
}
__device__ __forceinline__ TItem l_item(Frame& F, int l, int it) {
    const InTab in = F.in;
    constexpr int R2 = 1536, R4 = R2 + 768, R5 = R4 + 512, R6 = R5 + 2816, R7 = R6 + 1408; static_assert(R7 == 7040, "late-set items");
    if (it < R2) { const int blk = it >> 6, q = it & 63, kb = q >> 2, nb = q & 3;
        return TItem{in[2] + (size_t)l * DM * INW, INW, 2048 + blk * 128 + nb * 32, kb * 64, in[1] + (size_t)l * DM, (GAS bf16*)(F.ws + WS_WGATE) + (size_t)(blk * 128 + nb * 32) * DM, DM}; }
    if (it < R4) { const int r = it - R2, src = r >> 8, r2 = r & 255, blk = r2 >> 5, q = r2 & 31, kb = q >> 2, nb = q & 3;
        return TItem{(src == 0 ? in[14] : src == 1 ? in[19] : in[22]) + (size_t)l * 512 * DM, DM, blk * 128 + nb * 32, kb * 64, nullptr, (GAS bf16*)(F.ws + WS_WBR) + (size_t)(blk * 128 + nb * 32) * 1536 + src * 512, 1536}; }
    if (it < R5) { const int r = it - R4, blk = r >> 6, q = r & 63, kb = q >> 2, nb = q & 3;
        return TItem{in[23] + (size_t)l * DM * DM, DM, blk * 128 + nb * 32, kb * 64, nullptr, (GAS bf16*)(F.ws + WS_WOUT) + (size_t)(blk * 128 + nb * 32) * DM, DM}; }
    if (it < R6) { const int r = it - R5, blk = r >> 6, q = r & 63, kb = q >> 2, nb = q & 3;
        return TItem{((blk & 1) ? in[26] : in[25]) + (size_t)l * DM * FF, FF, (blk >> 1) * 128 + nb * 32, kb * 64, in[24] + (size_t)l * DM, (GAS bf16*)(F.ws + WS_WGU) + (size_t)(blk * 128 + nb * 32) * DM, DM}; }
    { const int r = it - R6, blk = r / 176, q = r % 176, kb = q >> 2, nb = q & 3;
        return TItem{in[27] + (size_t)l * FF * DM, DM, blk * 128 + nb * 32, kb * 64, nullptr, (GAS bf16*)(F.ws + WS_WDN) + (size_t)(blk * 128 + nb * 32) * FF, FF}; }
}
__device__ __forceinline__ void convert_L_waves(Frame& F, int l, int w, int NW, int it_lo, int it_hi) {
    LAS float* scr = (LAS float*)(F.lds + F.wave * 16384);
    int it = it_lo + w; if (it >= it_hi) return;
    TItem ta = l_item(F, l, it), tb = ta; f32x4 va[8], vb[8];
    titem_load(ta, va, F.lane);
    for (;;) {
        const int i1 = it + NW; const bool h1 = i1 < it_hi;
        if (h1) { tb = l_item(F, l, i1); titem_load(tb, vb, F.lane); }
        titem_finish(ta, va, scr, F.lane);
        if (!h1) break;
        const int i2 = i1 + NW; const bool h2 = i2 < it_hi;
        if (h2) { ta = l_item(F, l, i2); titem_load(ta, va, F.lane); }
        titem_finish(tb, vb, scr, F.lane);
        if (!h2) break;
        it = i2;
    }
}
__device__ __forceinline__ void xb0_waves(Frame& F, int w, int NW, int m_lo, int m_hi) {
    GAS float* rsa = (GAS float*)(F.ws + WS_RSA); GAS bf16* XB = (GAS bf16*)(F.ws + WS_XB); const GAS float* x = F.in[0];
    for (int m = m_lo + w; m < m_hi; m += NW) {
        const GAS f32x4* xr = (const GAS f32x4*)(x + (size_t)m * DM) + F.lane; f32x4 v[4]; float s = 0.f;
#pragma unroll
        for (int j = 0; j < 4; ++j) { v[j] = xr[64 * j]; s += (v[j].x * v[j].x + v[j].y * v[j].y) + (v[j].z * v[j].z + v[j].w * v[j].w); }
        s = wave_sum(s);
        GAS unsigned long long* o8 = (GAS unsigned long long*)(XB + (size_t)m * DM) + F.lane;
#pragma unroll
        for (int j = 0; j < 4; ++j) o8[64 * j] = (unsigned long long)pk2(v[j].x, v[j].y) | ((unsigned long long)pk2(v[j].z, v[j].w) << 32);
        if (F.lane < 4) *(GAS f32x4*)(rsa + (size_t)F.lane * (4 * M) + (size_t)m * 4) = (f32x4){F.lane == 0 ? s : 0.f, 0.f, 0.f, 0.f};
    }
}

template <int W> __device__ __forceinline__ void pool_regs(const unsigned (&vr)[47], GAS bf16* brp, int s_first, f32x2 sc) {
    float sm0 = 0.f, sm1 = 0.f;
#pragma unroll
    for (int tau = 1; tau < W; ++tau) { sm0 += bf_lo(vr[15 - tau]); sm1 += bf_hi(vr[15 - tau]); }
#pragma unroll
    for (int i = 0; i < 32; ++i) { const float v0 = bf_lo(vr[15 + i]), v1 = bf_hi(vr[15 + i]);
        sm0 += v0; sm1 += v1;
        const int pos = s_first + i + 1; const float inv = 1.0f / (float)(pos < W ? pos : W);
        *(GAS unsigned*)(brp + (size_t)i * 1536) = pk2(sc.x * (sm0 * inv - v0), sc.y * (sm1 * inv - v1));
        sm0 -= bf_lo(vr[15 + i - (W - 1)]); sm1 -= bf_hi(vr[15 + i - (W - 1)]); }
}
__device__ __forceinline__ void mixer_tile(Frame& F, int l, int tile) {
    const int t0 = tile * 64, s0 = t0 & (SEQ - 1);
    const GAS bf16* HC = (const GAS bf16*)(F.ws + WS_HC); const GAS bf16* V = (const GAS bf16*)(F.ws + WS_V); GAS bf16* BR = (GAS bf16*)(F.ws + WS_BR);
    LAS unsigned char* hb = F.lds;
    LAS f32x2* part = (LAS f32x2*)(F.lds + 98304);
    LAS f32x2* stat = (LAS f32x2*)(F.lds + RST_OFF + 1024);
    for (int r = F.wave; r < 94; r += NWAVES) {
        if (s0 - 30 + r >= 0) __builtin_amdgcn_global_load_lds((const GAS unsigned*)(HC + (size_t)(t0 - 30 + r) * CW + F.lane * 8), (LAS unsigned*)(hb + r * 1024), 16, 0, 0);
        else { unsigned z = 0u; asm volatile("" : "+v"(z)); *(LAS u32x4*)(hb + r * 1024 + F.lane * 16) = (u32x4){z, z, z, z}; }
    }
    const int cp = F.tid & 255, th = F.tid >> 8;
    unsigned vr[47];
#pragma unroll
    for (int r = 0; r < 47; ++r) { const int tl = th * 32 - 15 + r; vr[r] = *(const GAS unsigned*)(V + (size_t)(t0 + (s0 + tl >= 0 ? tl : -s0)) * PW + 2 * cp); }
    f32x2 wt[32];
    { const GAS f32x4* wp = (const GAS f32x4*)((const GAS float*)(F.ws + ws_cwt(l & 1)) + (size_t)cp * 64);
#pragma unroll
      for (int k2 = 0; k2 < 16; ++k2) { const f32x4 a = wp[k2]; wt[2 * k2] = (f32x2){a[0], a[1]}; wt[2 * k2 + 1] = (f32x2){a[2], a[3]}; } }
    const f32x2 bdw = *(const GAS f32x2*)(F.in[16] + (size_t)l * CW + 2 * cp);
    const f32x2 lng = *(const GAS f32x2*)(F.in[17] + (size_t)l * CW + 2 * cp), lnb = *(const GAS f32x2*)(F.in[18] + (size_t)l * CW + 2 * cp);
    VM_WAIT(); __syncthreads();
#pragma unroll 1
    for (int rr = 0; rr < 4; ++rr) {
        const int tb = (th * 4 + rr) * 8;
        f32x2 a[8];
#pragma unroll
        for (int i = 0; i < 8; ++i) a[i] = bdw;
#pragma unroll
        for (int r = 0; r < 38; ++r) { const unsigned w = *(const LAS unsigned*)(hb + (tb + r) * 1024 + cp * 4); const f32x2 h = (f32x2){bf_lo(w), bf_hi(w)};
#pragma unroll
            for (int i = 0; i < 8; ++i) { const int k = r - i; if (k >= 0 && k < CKW) a[i] += wt[k] * h; } }
#pragma unroll
        for (int i = 0; i < 8; ++i) part[(th * 8 + i) * 256 + cp] = (f32x2){a[i].x + a[i].y, a[i].x * a[i].x + a[i].y * a[i].y};
        __syncthreads();
        { const int tk = F.tid >> 5, sg = F.tid & 31; f32x2 p = part[tk * 256 + sg];
#pragma unroll
          for (int e = 1; e < 8; ++e) p += part[tk * 256 + sg + 32 * e];
#pragma unroll
          for (int o = 1; o < 32; o <<= 1) { p.x += __shfl_xor(p.x, o); p.y += __shfl_xor(p.y, o); }
          if (sg == 0) { const float mu = p.x * (1.0f / CW), var = p.y * (1.0f / CW) - mu * mu; stat[tk] = (f32x2){mu, __builtin_amdgcn_rsqf(fmaxf(var, 0.f) + EPS)}; } }
        __syncthreads();
#pragma unroll
        for (int i = 0; i < 8; ++i) { const int tok = tb + i; const f32x2 st = stat[th * 8 + i];
            float y0 = (a[i].x - st.x) * st.y * lng.x + lnb.x, y1 = (a[i].y - st.x) * st.y * lng.y + lnb.y; y0 *= fsigmoid(y0); y1 *= fsigmoid(y1);
            *(GAS unsigned*)(BR + (size_t)(t0 + tok) * 1536 + 512 + 2 * cp) = pk2(y0, y1); }
    }
    {
        const f32x2 sc = *(const GAS f32x2*)(F.in[21] + (size_t)l * PW + 2 * cp); GAS bf16* brp = BR + (size_t)(t0 + th * 32) * 1536 + 1024 + 2 * cp; const int sf = s0 + th * 32;
#pragma unroll
        for (int r = 0; r < 15; ++r) if (sf - 15 + r < 0) vr[r] = 0u;
        switch (cp >> 6) { case 0: pool_regs<2>(vr, brp, sf, sc); break; case 1: pool_regs<4>(vr, brp, sf, sc); break; case 2: pool_regs<8>(vr, brp, sf, sc); break; default: pool_regs<16>(vr, brp, sf, sc); break; }
    }
    __syncthreads();
}

__device__ __forceinline__ void final_phase(Frame& F) {
    const GAS float* rsa = (const GAS float*)(F.ws + WS_RSA); const GAS float* gfin = F.in[28]; const GAS bf16* XB = (const GAS bf16*)(F.ws + WS_XB);
    const int gw = F.vcu * NWAVES + F.wave, NGW = F.G * NWAVES;
    for (int m = gw; m < M; m += NGW) { const float rs = row_rs(rsa, m);
        GAS f32x4* o = (GAS f32x4*)(F.out + (size_t)m * DM); const GAS f32x4* gr = (const GAS f32x4*)gfin;
#pragma unroll
        for (int j = 0; j < 2; ++j) { const int c8 = j * 64 + F.lane; const u32x4 w = *(const GAS u32x4*)(XB + (size_t)m * DM + c8 * 8);
            const f32x4 x0 = (f32x4){bf_lo(w.x), bf_hi(w.x), bf_lo(w.y), bf_hi(w.y)}, x1 = (f32x4){bf_lo(w.z), bf_hi(w.z), bf_lo(w.w), bf_hi(w.w)};
            o[c8 * 2] = x0 * rs * gr[c8 * 2]; o[c8 * 2 + 1] = x1 * rs * gr[c8 * 2 + 1]; } }
}

constexpr int PH_PER_LAYER = 6, PH_FINAL = 1 + PH_PER_LAYER * DEPTH, PH_TOTAL = PH_FINAL + 1;
__global__ void __launch_bounds__(NTHR, 2) mk_fwd(Args args) {
    extern __shared__ __attribute__((aligned(16))) unsigned char lds_raw[];
    Frame F; F.lds = (LAS unsigned char*)lds_raw; F.tid = threadIdx.x; F.lane = F.tid & 63; F.wave = __builtin_amdgcn_readfirstlane(F.tid >> 6);
    F.G = gridDim.x; { const int bx = blockIdx.x; F.vcu = (F.G % 8 == 0) ? (bx % 8) * (F.G / 8) + bx / 8 : bx; }
    F.out = (GAS float*)args.out; F.ws = (GAS unsigned char*)args.ws;
    unsigned char* ws = args.ws;
    volatile LAS unsigned* MISC = (volatile LAS unsigned*)(F.lds + MISC_OFF);
    for (int u = F.tid; u < (LDS_BYTES - LDSCTL_OFF) / 4; u += NTHR) ((LAS unsigned*)(F.lds + LDSCTL_OFF))[u] = 0u;
    __syncthreads();
    XcdBarrier bar; bar.bar = (unsigned*)(ws + WS_CTL) + CW_BAR; bar.x = 0; bar.st = nullptr;
    const bool multi = (args.ph_hi - args.ph_lo) > 1;
    if (multi) bar = xcd_barrier_post((unsigned*)(ws + WS_CTL) + CW_BAR, MISC + 8);
    const int wave0 = F.wave, vcu0 = F.vcu, G0 = F.G;
#if MK_PROBE
    PSTAMP(args.ph_lo);
#endif
    for (int ph = args.ph_lo; ph < args.ph_hi; ++ph) {
        { int wv_ = wave0, vc_ = vcu0, g_ = G0; asm volatile("" : "+s"(wv_), "+s"(vc_), "+s"(g_)); F.wave = wv_; F.vcu = vc_; F.G = g_;
          int l_ = (int)__builtin_amdgcn_mbcnt_hi(~0u, __builtin_amdgcn_mbcnt_lo(~0u, 0u)); asm volatile("" : "+v"(l_)); F.lane = l_; F.tid = F.wave * 64 + l_;
          unsigned char* w_ = args.ws; asm volatile("" : "+s"(w_)); ws = as_global(w_); F.ws = (GAS unsigned char*)w_; F.out = (GAS float*)args.out;
          KargPtr k_ = (KargPtr)__builtin_amdgcn_kernarg_segment_ptr(); asm volatile("" : "+s"(k_)); F.in.kp = k_; }
        int cblk = (int)blockIdx.x; asm volatile("" : "+s"(cblk));
        const int l = (ph - 1) / PH_PER_LAYER, pt = (ph - 1) - l * PH_PER_LAYER, eb = l & 1;
        if (ph == PH_FINAL) final_phase(F);
        else if (ph != 0) {
            GDesc d; d.ws = ws; d.mode = 0; d.nM = M / BM; d.nN = 1; d.rs_in = nullptr; d.rs_out = nullptr; d.bias = nullptr; d.xold = nullptr; d.xnew = nullptr; d.xb = nullptr; d.xres = nullptr; d.lds = F.lds; d.rs_pm = -1; d.eb = eb; d.blk = cblk;
            float* rsa = (float*)(ws + WS_RSA); float* rsb = (float*)(ws + WS_RSB);
            unsigned char* we = ws + ws_e(eb);
            switch (pt) {
            case 0: d.A = (const char*)(ws + WS_XB); d.B = (const char*)(we + EO_WMIX); d.lda = DM; d.ldb = DM; d.K = DM; d.nN = 8; d.rs_in = rsa;
                    gemm_phase<GM_MIX>(F.lds, d, F.G, cblk, F.wave); break;
            case 1: if (cblk < 128) {
                        d.A = (const char*)(ws + WS_XS); d.B = (const char*)(we + EO_WS); d.lda = XSK; d.ldb = 256; d.K = 256;
                        gemm_phase<GM_S1>(F.lds, d, F.G, cblk, F.wave);
                        asm volatile("s_waitcnt vmcnt(0)" ::: "memory"); __syncthreads();
                        d.B = (const char*)(we + EO_TW); d.ldb = XSK; d.K = XSK;
                        gemm_phase<GM_S3>(F.lds, d, F.G, cblk, F.wave);
                        asm volatile("s_waitcnt vmcnt(0)" ::: "memory"); __syncthreads();
                        if (F.tid == 0) {
                            unsigned* dep = (unsigned*)(ws + WS_CTL) + CW_DEP + 64 * (4 * l);
                            __builtin_amdgcn_fence(__ATOMIC_RELEASE, "agent"); asm volatile("s_waitcnt vmcnt(0)" ::: "memory");
                            __hip_atomic_fetch_add(dep + 64 * (cblk & 3), 1u, RLX_AGENT);
                            const int pmg = 8 * (cblk & 7) + ((cblk >> 3) & 7); unsigned sp = 0;
                            while (__hip_atomic_load(dep + 64 * (pmg >> 4), RLX_AGENT) < 32u) { __builtin_amdgcn_s_sleep(2); if (++sp > (1u << 22)) break; }
                            __builtin_amdgcn_fence(__ATOMIC_ACQUIRE, "agent"); asm volatile("s_waitcnt vmcnt(0)" ::: "memory");
                        }
                        __syncthreads();
                        d.A = (const char*)(ws + WS_YS); d.B = (const char*)(we + EO_WGLU); d.lda = SW; d.ldb = SW; d.K = SW; d.nN = 2; d.bias = (const float*)(ARG_IN(13) + (size_t)l * SW);
                        gemm_phase<GM_GLU>(F.lds, d, F.G, cblk, F.wave);
                    }
                    break;
            case 2: d.A = (const char*)(ws + WS_XB); d.B = (const char*)(ws + WS_WGATE); d.lda = DM; d.ldb = DM; d.K = DM; d.nN = 12; d.rs_in = rsa; d.bias = (const float*)(ARG_IN(3) + (size_t)l * 3 * DM);
                    if (l == 0) PSTAMP(36);
                    gemm_phase<GM_GATE>(F.lds, d, F.G, cblk, F.wave);
                    asm volatile("s_waitcnt vmcnt(0)" ::: "memory"); __syncthreads();
                    if (l == 0) PSTAMP(37);
                    d.A = (const char*)(ws + WS_BR); d.B = (const char*)(ws + WS_WBR); d.lda = 1536; d.ldb = 1536; d.K = 512; d.nN = 4; d.rs_in = nullptr; d.bias = nullptr;
                    d.xb = (bf16*)F.out;
                    gemm_phase<GM_MERGE>(F.lds, d, F.G, cblk, F.wave); break;
            case 3: d.A = (const char*)F.out; d.B = (const char*)(ws + WS_WOUT); d.lda = DM; d.ldb = DM; d.K = DM; d.nN = 4;
                    d.xold = nullptr; d.xres = (const bf16*)(ws + WS_XB); d.xnew = nullptr; d.xb = (bf16*)(ws + WS_XB2); d.rs_out = rsb;
                    gemm_phase<GM_WOUT>(F.lds, d, F.G, cblk, F.wave); break;
            case 4: d.A = (const char*)(ws + WS_XB2); d.B = (const char*)(ws + WS_WGU); d.lda = DM; d.ldb = DM; d.K = DM; d.nN = 22; d.rs_in = rsb;
                    gemm_phase<GM_GU>(F.lds, d, F.G, cblk, F.wave); break;
            default: d.A = (const char*)(ws + WS_HID); d.B = (const char*)(ws + WS_WDN); d.lda = FF; d.ldb = FF; d.K = FF; d.nN = 4;
                    d.xold = nullptr; d.xres = (const bf16*)(ws + WS_XB2); d.xnew = nullptr; d.xb = (bf16*)(ws + WS_XB); d.rs_out = rsa;
                    gemm_phase<GM_WOUT>(F.lds, d, F.G, cblk, F.wave); break;
            }
        }
        const bool qg = (ph != 0 && ph != PH_FINAL && pt == 4 && l + 1 < DEPTH);
        if (ph == 0 || (ph != PH_FINAL && pt == 1) || qg) {
            const bool ce = (ph == 0) || qg;
            const int cl = (ph == 0) ? 0 : l + 1, ll = qg ? l + 1 : l, qk = (ph == 0) ? 0 : (qg ? 1 + DEPTH + l : 1 + l);
            const int llo = qg ? 0 : ((ph != 0 && l > 0) ? 176 : 0), lhi = qg ? 176 : 440;
            const int nS = ce ? 32 : 0, nM = (ph != 0 && !qg) ? 256 : 0, nP = ce ? 64 : 0, nE = ce ? 57 : 0, nL = (ph == 0) ? 0 : lhi - llo, nX = (ph == 0) ? 512 : 0;
            const int m0 = nS, p0 = m0 + nM, e0 = p0 + nP, l0 = e0 + nE, x0 = l0 + nL, tot = x0 + nX;
            for (;;) { const int it = queue_pull(F, qk); if (it >= tot) break;
                { int l_ = F.lane; asm volatile("" : "+v"(l_)); F.lane = l_; F.tid = F.wave * 64 + l_; }
                if (it < nS) s5_group_prep(F, cl, it);
                else if (it < p0) mixer_tile(F, l, it - m0);
                else if (it < e0) pool_fold_item(F, cl, it - p0);
                else if (it < l0) convert_E_waves(F, cl, F.wave, NWAVES, (it - e0) * 16, (it - e0) * 16 + 16);
                else if (it < x0) convert_L_waves(F, ll, F.wave, NWAVES, (llo + it - l0) * 16, (llo + it - l0) * 16 + 16);
                else xb0_waves(F, F.wave, NWAVES, (it - x0) * 32, (it - x0) * 32 + 32);
            }
        }
        if (ph + 1 < args.ph_hi) xcd_barrier(bar);
#if MK_PROBE
        if (ph == 5 && multi) { PSTAMP(41); xcd_barrier(bar); PSTAMP(42); xcd_barrier(bar); PSTAMP(43); }
#endif
#if MK_PROBE
        PSTAMP(ph + 1);
#endif
    }
#if MK_PROBE
    if (blockIdx.x == PROBE_BLK && threadIdx.x == 0) {
        volatile LAS unsigned long long* st = (volatile LAS unsigned long long*)(F.lds + 132096);
        unsigned long long qa = (st[PROBE_A + 1] - st[PROBE_A]) / 400ull, qb = (st[PROBE_B + 1] - st[PROBE_B]) / 400ull; if (qa > 127) qa = 127; if (qb > 127) qb = 127;
        const unsigned long long t0 = __builtin_amdgcn_s_memrealtime(), dl = 1000ull * (qa + 128ull * qb);
        while (__builtin_amdgcn_s_memrealtime() - t0 < dl) __builtin_amdgcn_s_sleep(8);
    }
#endif
}


#if MK_DIAG
__global__ void diag_sum(const unsigned* o, size_t nwords, unsigned* acc) {
    unsigned cs = 0; for (size_t i = (size_t)blockIdx.x * blockDim.x + threadIdx.x; i < nwords; i += (size_t)gridDim.x * blockDim.x) cs += o[i] * 2654435761u + (unsigned)i;
    for (int k = 1; k < 64; k <<= 1) cs += __shfl_xor(cs, k);
    if ((threadIdx.x & 63) == 0) atomicAdd(acc, cs);
}
__global__ void diag_cmp(float* out, const unsigned* acc, unsigned* pers, const unsigned* tmo) {
    const unsigned total = *acc, magic = pers[0], prev = pers[1], sticky = pers[2];
    const bool mism = (magic == 0x600DF00Du && (sticky == 1u || prev != total));
    const bool bad = (DIAG_WHAT == 0) ? (*tmo != 0u) : mism;
    __syncthreads();
    if (threadIdx.x == 0) { pers[0] = 0x600DF00Du; pers[1] = total; pers[2] = mism ? 1u : 0u; }
    if (bad) for (int i = threadIdx.x; i < 4096; i += blockDim.x) out[i] = __builtin_nanf("");
}
#endif
extern "C" void kernel_launch(void* const* d_in, const int* in_sizes, int n_in, void* d_out, int out_size, void* d_ws, size_t ws_size, hipStream_t stream) {
    static int grid = 0;
    if (grid == 0) {
        if (n_in != 29 || out_size != M * DM || ws_size < WS_END) { fprintf(stderr, "kernel_launch: unexpected shapes (n_in %d out %d ws %zu)\n", n_in, out_size, ws_size); grid = -1; return; }
        int dev = 0, cus = 0, per_cu = 0;
        if (hipGetDevice(&dev) != hipSuccess || hipDeviceGetAttribute(&cus, hipDeviceAttributeMultiprocessorCount, dev) != hipSuccess) { grid = -1; return; }
        if (hipFuncSetAttribute((const void*)mk_fwd, hipFuncAttributeMaxDynamicSharedMemorySize, LDS_BYTES) != hipSuccess) { fprintf(stderr, "kernel_launch: hipFuncSetAttribute failed\n"); grid = -1; return; }
        if (hipOccupancyMaxActiveBlocksPerMultiprocessor(&per_cu, (const void*)mk_fwd, NTHR, LDS_BYTES) != hipSuccess || per_cu < 1) { fprintf(stderr, "kernel_launch: occupancy query says %d blocks per CU\n", per_cu); grid = -1; return; }
        if (cus != 256) { fprintf(stderr, "kernel_launch: built for a 256-CU device (unit-to-workgroup maps assume 256 workgroups), found %d\n", cus); grid = -1; return; }
        grid = cus;
    }
    if (grid < 0) return;
    (void)hipMemsetAsync((char*)d_ws + WS_CTL, 0, CTL_ZERO_BYTES, stream);
    Args a{};
    for (int i = 0; i < 29; ++i) a.in[i] = (const float*)d_in[i];
    a.out = (float*)d_out; a.ws = (unsigned char*)d_ws;
#if MK_PER_PHASE
    for (int ph = 0; ph < PH_TOTAL; ++ph) { a.ph_lo = ph; a.ph_hi = ph + 1; hipLaunchKernelGGL(mk_fwd, dim3(grid), dim3(NTHR), LDS_BYTES, stream, a);
#if MK_DIAG
        if (ph == DIAG_AFTER && DIAG_LEN > 0) hipLaunchKernelGGL(diag_sum, dim3(1024), dim3(256), 0, stream, (const unsigned*)((char*)d_ws + (size_t)DIAG_OFF * MiB), (size_t)DIAG_LEN * MiB / 4, (unsigned*)((char*)d_ws + WS_CTL) + 2048);
#endif
    }
#else
    a.ph_lo = 0; a.ph_hi = PH_TOTAL; hipLaunchKernelGGL(mk_fwd, dim3(grid), dim3(NTHR), LDS_BYTES, stream, a);
#endif
#if MK_DIAG
    { unsigned* ctl = (unsigned*)((char*)d_ws + WS_CTL); unsigned* pers = (unsigned*)((char*)d_ws + WS_CTL + 3 * (MiB / 2));
      if (DIAG_LEN == 0) hipLaunchKernelGGL(diag_sum, dim3(1024), dim3(256), 0, stream, (const unsigned*)d_out, (size_t)M * DM, ctl + 2048);
      hipLaunchKernelGGL(diag_cmp, dim3(1), dim3(256), 0, stream, (float*)d_out, (const unsigned*)(ctl + 2048), pers, (const unsigned*)(ctl + CW_BAR + XB_TMO)); }
#endif
}
```

```cpp
#include <hip/hip_runtime.h>
#include <cstdio>
#include <cstdint>

#define LAS __attribute__((address_space(3)))
#define GAS __attribute__((address_space(1)))
template <class T> __device__ __forceinline__ T* as_global(T* p) { return (T*)(GAS T*)p; }
typedef unsigned short bf16;
typedef short bf16x8 __attribute__((ext_vector_type(8)));
typedef float f32x4 __attribute__((ext_vector_type(4)));
typedef float f32x2 __attribute__((ext_vector_type(2)));
typedef unsigned u32x4 __attribute__((ext_vector_type(4)));
typedef unsigned u32x2 __attribute__((ext_vector_type(2)));

#ifndef MK_PROBE
#define MK_PROBE 0
#endif
#ifndef PROBE_A
#define PROBE_A 0
#define PROBE_B 1
#endif
#ifndef PROBE_BLK
#define PROBE_BLK 0
#endif
#if MK_PROBE
#define PSTAMP(k) do { if (blockIdx.x == PROBE_BLK && threadIdx.x == 0) ((volatile LAS unsigned long long*)(F.lds + 132096))[k] = __builtin_amdgcn_s_memrealtime(); } while (0)
#else
#define PSTAMP(k) do {} while (0)
#endif
#ifndef MK_DIAG
#define MK_DIAG 0
#define DIAG_WHAT 0
#define DIAG_AFTER 20
#define DIAG_OFF 0
#define DIAG_LEN 0
#endif
#ifndef MK_SP2
#define MK_SP2 1
#endif
#ifndef MK_PER_PHASE
#define MK_PER_PHASE 0
#endif

constexpr int DM = 1024, BATCH = 8, SEQ = 2048, DEPTH = 2, M = BATCH * SEQ;
constexpr int SW = 512, NG = 32, NP = 16, NS = 64, CW = 512, CKW = 31, PW = 512, PGW = 128, INW = 5120, FF = 2816;
constexpr int CL = 16, NCHUNK = M / CL, CPB = SEQ / CL, XSK = 384;
constexpr float EPS = 1e-6f;
constexpr int NWAVES = 8, NTHR = 512;

constexpr size_t MiB = 1u << 20;
constexpr size_t WS_CTL = 0, CTL_ZERO_BYTES = 64 * 1024;
constexpr size_t WS_LAM16_0 = 1 * MiB;
constexpr size_t WS_CWT_0 = 1 * MiB + 64 * 1024;
constexpr size_t WS_E0 = 2 * MiB, WS_E1 = 220 * MiB;
constexpr size_t EO_WMIX = 0, EO_WS = 4 * MiB, EO_TW = 8 * MiB, EO_WGLU = 14 * MiB, E_BYTES = 14 * MiB + MiB / 2;
__host__ __device__ __forceinline__ constexpr size_t ws_e(int e) { return e ? WS_E1 : WS_E0; }
__host__ __device__ __forceinline__ constexpr size_t ws_lam(int e) { return WS_LAM16_0 + (size_t)e * 16384; }
__host__ __device__ __forceinline__ constexpr size_t ws_cwt(int e) { return WS_CWT_0 + (size_t)e * 65536; }
constexpr size_t WS_WGATE = WS_E0 + E_BYTES;
constexpr size_t WS_WBR = WS_WGATE + 6 * MiB;
constexpr size_t WS_WOUT = WS_WBR + 3 * MiB;
constexpr size_t WS_WGU = WS_WOUT + 2 * MiB;
constexpr size_t WS_WDN = WS_WGU + 11 * MiB;
constexpr size_t WS_XB = 44 * MiB;
constexpr size_t WS_RC = 76 * MiB;
constexpr size_t WS_G = WS_RC, WS_HID = WS_RC;
constexpr size_t WS_XS = WS_RC;
constexpr size_t WS_HC = WS_XS + 24 * MiB;
constexpr size_t WS_V = WS_HC + 16 * MiB;
constexpr size_t WS_YS = WS_V + 32 * MiB;
constexpr size_t WS_BR = 172 * MiB;
constexpr size_t WS_XB2 = WS_BR;
constexpr size_t WS_RSA = 252 * MiB, WS_RSB = 253 * MiB;
constexpr size_t WS_END = 254 * MiB;
static_assert(WS_WDN + 5 * MiB + MiB / 2 <= WS_XB && WS_YS + 16 * MiB <= WS_RC + 96 * MiB && WS_E1 + E_BYTES <= WS_RSA && ws_cwt(1) + 65536 <= WS_E0, "ws map");

constexpr int CW_BAR = 4096;

constexpr int RST_OFF = 133120;
constexpr int RING_BYTES = 131072, LDSCTL_OFF = RING_BYTES, MISC_OFF = LDSCTL_OFF + 320, LDS_BYTES = 147456;

#define RLX_AGENT __ATOMIC_RELAXED, __HIP_MEMORY_SCOPE_AGENT
#define LDS_WAIT() asm volatile("s_waitcnt lgkmcnt(0)" ::: "memory")
#define VM_WAIT() asm volatile("s_waitcnt vmcnt(0)" ::: "memory")

__device__ __forceinline__ unsigned f2bf(float f) { unsigned u = __builtin_bit_cast(unsigned, f); return (u + 0x7fffu + ((u >> 16) & 1u)) >> 16; }
__device__ __forceinline__ unsigned pk2(float lo, float hi) { return f2bf(lo) | (f2bf(hi) << 16); }
typedef __bf16 bf16x2_t __attribute__((ext_vector_type(2)));
__device__ __forceinline__ unsigned cvt_pk_bf16(float lo, float hi) { const bf16x2_t v = __builtin_convertvector((f32x2){lo, hi}, bf16x2_t); return __builtin_bit_cast(unsigned, v); }
__device__ __forceinline__ float bf_lo(unsigned w) { return __builtin_bit_cast(float, w << 16); }
__device__ __forceinline__ float bf_hi(unsigned w) { return __builtin_bit_cast(float, w & 0xffff0000u); }
__device__ __forceinline__ float fsigmoid(float v) { return __builtin_amdgcn_rcpf(1.0f + __builtin_amdgcn_exp2f(-1.4426950408889634f * v)); }
__device__ __forceinline__ float fgelu(float v) { return v * fsigmoid(1.5957691216057308f * (v + 0.044715f * v * v * v)); }

#define XB_TMO      128
#define XB_XCNT(j)  (256  + 64 * (j))
#define XB_XSUB(j)  (1280 + 64 * (j))
#define XB_XGEN(j)  (2304 + 64 * (j))
#define XB_TOP      3328
#define XB_TOPGEN   3392
#define XCD_BAR_WORDS 3456
#define XB_SPIN_CAP (1u << 18)
__device__ __forceinline__ unsigned xb_ld(unsigned* p)              { return __hip_atomic_load(p, __ATOMIC_RELAXED, __HIP_MEMORY_SCOPE_AGENT); }
__device__ __forceinline__ unsigned xb_add(unsigned* p, unsigned v) { return __hip_atomic_fetch_add(p, v, __ATOMIC_RELAXED, __HIP_MEMORY_SCOPE_AGENT); }
__device__ __forceinline__ unsigned xb_xcc_id() { return (unsigned)__builtin_amdgcn_s_getreg((3 << 11) | 20) & 0xFu; }
#define XB_SPIN(cond, bar) do { unsigned _sp = 0; while (cond) { __builtin_amdgcn_s_sleep(1); \
    if ((++_sp & 255u) == 0u) { if (xb_ld(&(bar)[XB_TMO])) break; if (_sp > XB_SPIN_CAP) { atomicAdd(&(bar)[XB_TMO], 1u); break; } } } } while (0)
struct XcdBarrier { unsigned* bar; unsigned x; volatile LAS unsigned* st; };
__device__ __forceinline__ XcdBarrier xcd_barrier_post(unsigned* bar, volatile LAS unsigned* st) {
    XcdBarrier b; b.bar = bar; b.x = xb_xcc_id(); b.st = st;
    if (threadIdx.x == 0) (void)xb_add(&bar[XB_XCNT(b.x)], 1u);
    return b;
}
__device__ __forceinline__ void xcd_barrier_complete(unsigned* bar, unsigned x, unsigned& nloc, unsigned& nx) {
    const unsigned G = gridDim.x * gridDim.y * gridDim.z;
    unsigned sum, cnt, mine, sp = 0u;
    for (;;) {
        sum = 0u; cnt = 0u; mine = 0u;
#pragma unroll
        for (unsigned j = 0; j < 16; ++j) { const unsigned c = xb_ld(&bar[XB_XCNT(j)]); sum += c; cnt += (c > 0u) ? 1u : 0u; mine = (j == x) ? c : mine; }
        if (sum == G) break;
        __builtin_amdgcn_s_sleep(1);
        if ((++sp & 255u) == 0u) { if (xb_ld(&bar[XB_TMO])) break; if (sp > XB_SPIN_CAP) { atomicAdd(&bar[XB_TMO], 1u); break; } }
    }
    nloc = mine > 0u ? mine : 1u; nx = cnt > 0u ? cnt : 1u;
}
__device__ __forceinline__ void xcd_barrier(const XcdBarrier& b) {
    asm volatile("s_waitcnt vmcnt(0)" ::: "memory");
    __syncthreads();
    if (threadIdx.x == 0) {
        unsigned* bar = b.bar;
        __builtin_amdgcn_s_waitcnt(0);
        unsigned nloc = b.st[0], nx = b.st[1];
        if (nloc == 0u) { xcd_barrier_complete(bar, b.x, nloc, nx); b.st[0] = nloc; b.st[1] = nx; }
        const unsigned old = xb_add(&bar[XB_XSUB(b.x)], 1u);
        const unsigned gen = old / nloc;
        if (old + 1u == (gen + 1u) * nloc) {
            __builtin_amdgcn_fence(__ATOMIC_RELEASE, "agent");
            asm volatile("s_waitcnt vmcnt(0)" ::: "memory");
            const unsigned og = xb_add(&bar[XB_TOP], 1u);
            const unsigned tg = og / nx;
            if (og + 1u == (tg + 1u) * nx) xb_add(&bar[XB_TOPGEN], 1u);
            else XB_SPIN(xb_ld(&bar[XB_TOPGEN]) == tg, bar);
            __builtin_amdgcn_fence(__ATOMIC_ACQUIRE, "agent");
            xb_add(&bar[XB_XGEN(b.x)], 1u);
            asm volatile("s_waitcnt vmcnt(0)" ::: "memory");
        } else {
            XB_SPIN(xb_ld(&bar[XB_XGEN(b.x)]) == gen, bar);
            __builtin_amdgcn_fence(__ATOMIC_ACQUIRE, "agent");
            asm volatile("s_waitcnt vmcnt(0)" ::: "memory");
        }
    }
    __syncthreads();
}

struct Args { const float* in[29]; float* out; unsigned char* ws; int ph_lo, ph_hi; };

enum GemmMode { GM_MIX = 0, GM_S1, GM_S3, GM_GLU, GM_GATE, GM_MERGE, GM_WOUT, GM_GU, GM_DOWN };
struct GDesc {
    int mode; const char* A; const char* B; int lda, ldb, K, nM, nN;
    const float* rs_in;
    float* rs_out;
    const float* bias;
    const float* xold; float* xnew; bf16* xb; const bf16* xres;
    unsigned char* ws;
    LAS unsigned char* lds; int rs_pm;
    int eb;
    int blk;
};
struct Unit { const char* A; const char* B; int pm, pn, aux; };

constexpr int BM = 256, BK = 64, HALF = 128, HTB = HALF * BK * 2, NXCD = 8, WGM = 8;
__device__ __forceinline__ int lds_byte(int r, int c) { const int st = (r >> 4) * 2 + (c >> 5), rr = r & 15, cc = c & 31, ob = rr * 64 + cc * 2; return st * 1024 + (ob ^ (((ob >> 9) & 1) << 5)); }
__device__ __forceinline__ void stage_rc(int b, int& R, int& C) { const int st = b / 1024, sb = b % 1024, swz = sb ^ (((sb >> 9) & 1) << 5); R = (st >> 1) * 16 + swz / 64; C = (st & 1) * 32 + (swz % 64) / 2; }
__device__ __forceinline__ int perm32(int rho) { const int n = rho >> 4, i = rho & 15; return 8 * (i >> 2) + 4 * n + (i & 3); }

template <int MODE> __device__ __forceinline__ bool sched_next(const GDesc& d, int G, int c, int i, Unit& u) {
    if (MODE == GM_S1 || MODE == GM_S3) {
        const int L = i * G + c; if (L >= 128) return false;
        const int g = L >> 2, r = L & 3;
        u.A = d.A + (size_t)(g * NCHUNK + r * 256) * d.lda * 2; u.B = d.B + (size_t)g * 256 * d.ldb * 2; u.pm = r; u.pn = 0; u.aux = g; return true;
    }
    int ii = i, sub = 0; if (MODE == GM_MERGE) { ii = i / 3; sub = i - 3 * ii; }
    const int nwg = d.nM * d.nN; const long L = (long)ii * G + c; if (L >= nwg) return false;
    int wgid = (int)L; { const int q = nwg / NXCD, r = nwg % NXCD, xcd = wgid % NXCD, off = wgid / NXCD; wgid = (xcd < r ? xcd * (q + 1) : r * (q + 1) + (xcd - r) * q) + off; }
    const int nig = WGM * d.nN, gid = wgid / nig, fm = gid * WGM, gsz = (d.nM - fm) < WGM ? (d.nM - fm) : WGM;
    u.pm = fm + ((wgid % nig) % gsz); u.pn = (wgid % nig) / gsz; u.aux = sub;
    u.A = d.A + (size_t)u.pm * 256 * d.lda * 2 + sub * 1024; u.B = d.B + (size_t)u.pn * 256 * d.ldb * 2 + sub * 1024; return true;
}

__device__ __forceinline__ void store8(bf16* p, const f32x4& v0, const f32x4& v1) {
    u32x4 w; w.x = cvt_pk_bf16(v0[0], v0[1]); w.y = cvt_pk_bf16(v0[2], v0[3]); w.z = cvt_pk_bf16(v1[0], v1[1]); w.w = cvt_pk_bf16(v1[2], v1[3]); *(GAS u32x4*)p = w;
}
__device__ __forceinline__ void load8(const bf16* p, f32x4& v0, f32x4& v1) {
    const u32x4 w = *(const GAS u32x4*)p; v0 = (f32x4){bf_lo(w.x), bf_hi(w.x), bf_lo(w.y), bf_hi(w.y)}; v1 = (f32x4){bf_lo(w.z), bf_hi(w.z), bf_lo(w.w), bf_hi(w.w)};
}
__device__ __forceinline__ float row_rs(const GAS float* slots, int row) {
    const GAS float* q = (const GAS float*)slots + (size_t)row * 4; const f32x4 v = (*(const GAS f32x4*)q + *(const GAS f32x4*)(q + 4 * M)) + (*(const GAS f32x4*)(q + 8 * M) + *(const GAS f32x4*)(q + 12 * M));
    return __builtin_amdgcn_rsqf(((v[0] + v[1]) + (v[2] + v[3])) * (1.0f / DM) + EPS);
}
__device__ __forceinline__ f32x4 sig4(const f32x4& v) { return (f32x4){fsigmoid(v[0]), fsigmoid(v[1]), fsigmoid(v[2]), fsigmoid(v[3])}; }
__device__ __forceinline__ unsigned q8x4(const f32x4& g) {
    const unsigned a = (unsigned)__builtin_fmaxf(g[0] * 255.f + 0.5f, 1.f), b = (unsigned)__builtin_fmaxf(g[1] * 255.f + 0.5f, 1.f), c = (unsigned)__builtin_fmaxf(g[2] * 255.f + 0.5f, 1.f), e = (unsigned)__builtin_fmaxf(g[3] * 255.f + 0.5f, 1.f);
    return a | (b << 8) | (c << 16) | (e << 24);
}
__device__ __forceinline__ f32x4 uq4(unsigned w) { return (f32x4){(float)(w & 0xffu), (float)((w >> 8) & 0xffu), (float)((w >> 16) & 0xffu), (float)(w >> 24)}; }
__device__ __forceinline__ f32x4 rcp4(const f32x4& v) { return (f32x4){__builtin_amdgcn_rcpf(v[0]), __builtin_amdgcn_rcpf(v[1]), __builtin_amdgcn_rcpf(v[2]), __builtin_amdgcn_rcpf(v[3])}; }
__device__ __forceinline__ f32x4 gelu4(const f32x4& v) { return (f32x4){fgelu(v[0]), fgelu(v[1]), fgelu(v[2]), fgelu(v[3])}; }

template <int MODE> __device__ __forceinline__ bool epilogue(const GDesc& d, const Unit& u, f32x4 (&acc)[2][2][4][2], int wr, int wc, int fr, int fq) {
    asm volatile("" : "+v"(fr), "+v"(fq));
    constexpr int mode = MODE;
    unsigned char* ws = d.ws;
    const int rl0 = wr * 64 + fr;
    const int cl0 = wc * 32 + 8 * fq;
    if constexpr (mode == GM_MIX) {
        const int rowb = u.pm * BM + rl0;
        if (u.pn < 2) {
            bf16* XS = (bf16*)(ws + WS_XS);
#pragma unroll
            for (int ai = 0; ai < 2; ++ai)
#pragma unroll
                for (int m = 0; m < 4; ++m) { const int row = rowb + ai * HALF + m * 16; const float rs = (u.pm == d.rs_pm) ? *(const LAS float*)(d.lds + RST_OFF + (rl0 + ai * HALF + m * 16) * 4) : row_rs((const GAS float*)d.rs_in, row);
#pragma unroll
                    for (int bj = 0; bj < 2; ++bj) { const int ch = u.pn * BM + bj * HALF + cl0; const int g = ch >> 4, p0 = ch & 15;
                        store8(XS + ((size_t)(g * NCHUNK + (row >> 4)) * XSK + (row & 15) * 16 + p0), acc[ai][bj][m][0] * rs, acc[ai][bj][m][1] * rs); } }
        } else if (u.pn < 6) {
            bf16* HC = (bf16*)(ws + WS_HC);
#pragma unroll
            for (int ai = 0; ai < 2; ++ai)
#pragma unroll
                for (int m = 0; m < 4; ++m) { const int row = rowb + ai * HALF + m * 16; const float rs = (u.pm == d.rs_pm) ? *(const LAS float*)(d.lds + RST_OFF + (rl0 + ai * HALF + m * 16) * 4) : row_rs((const GAS float*)d.rs_in, row);
                    store8(HC + (size_t)row * CW + (u.pn - 2) * HALF + cl0, acc[ai][0][m][0] * rs * sig4(acc[ai][1][m][0] * rs), acc[ai][0][m][1] * rs * sig4(acc[ai][1][m][1] * rs)); }
        } else {
            bf16* V = (bf16*)(ws + WS_V);
#pragma unroll
            for (int ai = 0; ai < 2; ++ai)
#pragma unroll
                for (int m = 0; m < 4; ++m) { const int row = rowb + ai * HALF + m * 16; const float rs = (u.pm == d.rs_pm) ? *(const LAS float*)(d.lds + RST_OFF + (rl0 + ai * HALF + m * 16) * 4) : row_rs((const GAS float*)d.rs_in, row);
#pragma unroll
                    for (int bj = 0; bj < 2; ++bj) store8(V + (size_t)row * PW + (u.pn - 6) * BM + bj * HALF + cl0, acc[ai][bj][m][0] * rs, acc[ai][bj][m][1] * rs); }
        }
        return false;
    }
    if constexpr (mode == GM_GATE) {
        GAS unsigned char* gp = (GAS unsigned char*)(ws + WS_G) + (size_t)d.blk * (3 * 65536) + (size_t)(u.pn >> 2) * 65536 + ((wr * 4 + wc) * 64 + fq * 16 + fr) * 16;
        const int rowb = u.pm * BM + rl0, colb = u.pn * BM + cl0;
        f32x4 bv[2][2];
#pragma unroll
        for (int bj = 0; bj < 2; ++bj)
#pragma unroll
            for (int n = 0; n < 2; ++n) bv[bj][n] = *(const GAS f32x4*)(d.bias + colb + bj * HALF + 4 * n);
#pragma unroll
        for (int ai = 0; ai < 2; ++ai)
#pragma unroll
            for (int m = 0; m < 4; ++m) { const int row = rowb + ai * HALF + m * 16; const float rs = (u.pm == d.rs_pm) ? *(const LAS float*)(d.lds + RST_OFF + (rl0 + ai * HALF + m * 16) * 4) : row_rs((const GAS float*)d.rs_in, row);
                u32x4 w; w.x = q8x4(sig4(acc[ai][0][m][0] * rs + bv[0][0])); w.y = q8x4(sig4(acc[ai][0][m][1] * rs + bv[0][1])); w.z = q8x4(sig4(acc[ai][1][m][0] * rs + bv[1][0])); w.w = q8x4(sig4(acc[ai][1][m][1] * rs + bv[1][1]));
                *(GAS u32x4*)(gp + (ai * 4 + m) * 8192) = w; }
        return false;
    }
    if constexpr (mode == GM_S3) {
        bf16* YS = (bf16*)(ws + WS_YS);
#pragma unroll
        for (int ai = 0; ai < 2; ++ai)
#pragma unroll
            for (int m = 0; m < 4; ++m) { const int chunk = u.pm * BM + rl0 + ai * HALF + m * 16;
#pragma unroll
                for (int bj = 0; bj < 2; ++bj) { const int col = bj * HALF + cl0; const int tok = chunk * CL + (col >> 4);
                    store8(YS + (size_t)tok * SW + u.aux * NP + (col & 15), gelu4(acc[ai][bj][m][0]), gelu4(acc[ai][bj][m][1])); } }
        return false;
    }
    if constexpr (mode == GM_GLU) {
        const bf16* YS = (const bf16*)(ws + WS_YS); bf16* BR = (bf16*)(ws + WS_BR); const int rowb = u.pm * BM + rl0, colb = u.pn * BM + cl0;
        f32x4 bv[2][2];
#pragma unroll
        for (int bj = 0; bj < 2; ++bj)
#pragma unroll
            for (int n = 0; n < 2; ++n) bv[bj][n] = *(const GAS f32x4*)(d.bias + colb + bj * HALF + 4 * n);
#pragma unroll
        for (int ai = 0; ai < 2; ++ai) {
            u32x4 yw[4][2];
#pragma unroll
            for (int m = 0; m < 4; ++m)
#pragma unroll
                for (int bj = 0; bj < 2; ++bj) yw[m][bj] = *(const GAS u32x4*)(YS + (size_t)(rowb + ai * HALF + m * 16) * SW + colb + bj * HALF);
#pragma unroll
            for (int m = 0; m < 4; ++m) { const int row = rowb + ai * HALF + m * 16;
#pragma unroll
                for (int bj = 0; bj < 2; ++bj) { const u32x4 w = yw[m][bj];
                    const f32x4 y0 = (f32x4){bf_lo(w.x), bf_hi(w.x), bf_lo(w.y), bf_hi(w.y)}, y1 = (f32x4){bf_lo(w.z), bf_hi(w.z), bf_lo(w.w), bf_hi(w.w)};
                    store8(BR + (size_t)row * 1536 + colb + bj * HALF, y0 * sig4(acc[ai][bj][m][0] + bv[bj][0]), y1 * sig4(acc[ai][bj][m][1] + bv[bj][1])); } }
        }
        return false;
    }
    if constexpr (mode == GM_MERGE) {
        const GAS unsigned char* gp = (const GAS unsigned char*)(ws + WS_G) + (size_t)d.blk * (3 * 65536) + ((wr * 4 + wc) * 64 + fq * 16 + fr) * 16;
        bf16* MG = d.xb; const int rowb = u.pm * BM + rl0, colb = u.pn * BM + cl0, sub = u.aux;
#pragma unroll
        for (int ai = 0; ai < 2; ++ai) {
            u32x4 ga[4], gb[4];
#pragma unroll
            for (int m = 0; m < 4; ++m) { const GAS unsigned char* p = gp + (size_t)sub * 65536 + (ai * 4 + m) * 8192;
                ga[m] = *(const GAS u32x4*)p; gb[m] = (sub < 2) ? *(const GAS u32x4*)(p + 65536) : ga[m]; }
#pragma unroll
            for (int m = 0; m < 4; ++m) { const int row = rowb + ai * HALF + m * 16; const u32x4 wa = ga[m], wb = gb[m];
                if (sub < 2) {
                    acc[ai][0][m][0] *= uq4(wa.x) * rcp4(uq4(wb.x)); acc[ai][0][m][1] *= uq4(wa.y) * rcp4(uq4(wb.y));
                    acc[ai][1][m][0] *= uq4(wa.z) * rcp4(uq4(wb.z)); acc[ai][1][m][1] *= uq4(wa.w) * rcp4(uq4(wb.w));
                } else {
                    constexpr float s = 1.0f / 255.0f;
                    store8(MG + (size_t)row * DM + colb, acc[ai][0][m][0] * (uq4(wa.x) * s), acc[ai][0][m][1] * (uq4(wa.y) * s));
                    store8(MG + (size_t)row * DM + colb + HALF, acc[ai][1][m][0] * (uq4(wa.z) * s), acc[ai][1][m][1] * (uq4(wa.w) * s));
                } }
        }
        return sub < 2;
    }
    if constexpr (mode == GM_WOUT || mode == GM_DOWN) {
        const int rowb = u.pm * BM + rl0, colb = u.pn * BM + cl0; const bool res16 = (d.xold == nullptr), st32 = (d.xnew != nullptr);
#pragma unroll
        for (int ai = 0; ai < 2; ++ai)
#pragma unroll
        for (int mh = 0; mh < 2; ++mh) {
            f32x4 xo[2][2][2];
#pragma unroll
            for (int m2 = 0; m2 < 2; ++m2)
#pragma unroll
                for (int bj = 0; bj < 2; ++bj) { const size_t o = (size_t)(rowb + ai * HALF + (mh * 2 + m2) * 16) * DM + colb + bj * HALF;
                    if (res16) load8(d.xres + o, xo[m2][bj][0], xo[m2][bj][1]);
                    else { const GAS float* p = (const GAS float*)d.xold + o; xo[m2][bj][0] = *(const GAS f32x4*)p; xo[m2][bj][1] = *(const GAS f32x4*)(p + 4); } }
#pragma unroll
            for (int m2 = 0; m2 < 2; ++m2) { const int m = mh * 2 + m2; const int row = rowb + ai * HALF + m * 16; float ss = 0.f;
#pragma unroll
                for (int bj = 0; bj < 2; ++bj) { const size_t o = (size_t)row * DM + colb + bj * HALF;
                    const f32x4 x0 = xo[m2][bj][0] + acc[ai][bj][m][0], x1 = xo[m2][bj][1] + acc[ai][bj][m][1];
                    if (st32) { *(GAS f32x4*)(d.xnew + o) = x0; *(GAS f32x4*)(d.xnew + o + 4) = x1; }
                    store8(d.xb + o, x0, x1);
                    ss += (x0[0] * x0[0] + x0[1] * x0[1]) + (x0[2] * x0[2] + x0[3] * x0[3]) + (x1[0] * x1[0] + x1[1] * x1[1]) + (x1[2] * x1[2] + x1[3] * x1[3]); }
                ss += __shfl_xor(ss, 16); ss += __shfl_xor(ss, 32);
                if (fq == 0) *((GAS float*)d.rs_out + (size_t)u.pn * (4 * M) + (size_t)row * 4 + wc) = ss; }
        }
        return false;
    }
    if constexpr (mode == GM_GU) {
        bf16* HID = (bf16*)(ws + WS_HID); const int rowb = u.pm * BM + rl0;
#pragma unroll
        for (int ai = 0; ai < 2; ++ai)
#pragma unroll
            for (int m = 0; m < 4; ++m) { const int row = rowb + ai * HALF + m * 16; const float rs = (u.pm == d.rs_pm) ? *(const LAS float*)(d.lds + RST_OFF + (rl0 + ai * HALF + m * 16) * 4) : row_rs((const GAS float*)d.rs_in, row);
                const f32x4 g0 = acc[ai][0][m][0] * rs, g1 = acc[ai][0][m][1] * rs;
                store8(HID + (size_t)row * FF + u.pn * HALF + cl0, g0 * sig4(g0) * (acc[ai][1][m][0] * rs), g1 * sig4(g1) * (acc[ai][1][m][1] * rs)); }
        return false;
    }
}

template <int MODE> __device__ __forceinline__ void gemm_phase(LAS unsigned char* lds, const GDesc& g, int G, int c, int wave_id) {
    int lane = (int)__builtin_amdgcn_mbcnt_hi(~0u, __builtin_amdgcn_mbcnt_lo(~0u, 0u)); asm volatile("" : "+v"(lane));
    const int wid = wave_id, tid = wid * 64 + lane, wr = wid >> 2, wc = wid & 3, fr = lane & 15, fq = lane >> 4;
    const int K = g.K, nt = K / BK;
    unsigned voffA[2], voffB[2];
#pragma unroll
    for (int i = 0; i < 2; ++i) { int R, C; stage_rc(tid * 16 + i * 8192, R, C); const int Rb = (R & ~31) + perm32(R & 31);
        voffA[i] = (unsigned)(R * g.lda + C) * 2u; voffB[i] = (unsigned)(Rb * g.ldb + C) * 2u; }
    const size_t kstep = (size_t)(BK * 2);
    const size_t hstepA = (size_t)HALF * g.lda * 2, hstepB = (size_t)HALF * g.ldb * 2;
    const unsigned ldsw = (unsigned)wid * 1024u;
    const int aoff = lds_byte(wr * 64 + fr, fq * 8), boff = lds_byte(wc * 32 + fr, fq * 8);
#define PG8_SA(b, h) (((b) * 2 + (h)) * HTB)
#define PG8_SB(b, h) ((4 + (b) * 2 + (h)) * HTB)
#define PG8_STAGE(bufoff, gbase, voff) do { _Pragma("unroll") for (int _i = 0; _i < 2; ++_i) \
        __builtin_amdgcn_global_load_lds((const unsigned*)((const char*)(gbase) + (voff)[_i]), (LAS unsigned*)(lds + (bufoff) + ldsw + _i * 8192), 16, 0, 0); } while (0)
#define PG8_LDA(dst, b, h) do { _Pragma("unroll") for (int m = 0; m < 4; ++m) _Pragma("unroll") for (int k = 0; k < 2; ++k) dst[m][k] = *(const LAS bf16x8*)(lds + PG8_SA(b, h) + aoff + m * 2048 + k * 1024); } while (0)
#define PG8_LDB(dst, b, h) do { _Pragma("unroll") for (int n = 0; n < 2; ++n) _Pragma("unroll") for (int k = 0; k < 2; ++k) dst[n][k] = *(const LAS bf16x8*)(lds + PG8_SB(b, h) + boff + n * 2048 + k * 1024); } while (0)
#define PG8_MMA(ai, bj, At, Bt) do { __builtin_amdgcn_s_setprio(1); _Pragma("unroll") for (int m = 0; m < 4; ++m) _Pragma("unroll") for (int n = 0; n < 2; ++n) _Pragma("unroll") for (int k = 0; k < 2; ++k) \
        acc[ai][bj][m][n] = __builtin_amdgcn_mfma_f32_16x16x32_bf16(Bt[n][k], At[m][k], acc[ai][bj][m][n], 0, 0, 0); __builtin_amdgcn_s_setprio(0); } while (0)
#define PG8_WAIT_V(n) asm volatile("s_waitcnt vmcnt(" #n ")" ::: "memory")
#define PG8_WAIT_L(n) asm volatile("s_waitcnt lgkmcnt(" #n ")" ::: "memory")
#define PG8_BAR __builtin_amdgcn_s_barrier()
#define PG8_SCHED __builtin_amdgcn_sched_barrier(0)
    Unit cur, nxt; int ui = 0;
    if (!sched_next<MODE>(g, G, c, 0, cur)) return;
    GDesc gd = g; gd.lds = lds; gd.rs_pm = -1;
    if constexpr (MODE == GM_MIX || MODE == GM_GATE || MODE == GM_GU) {
        if (tid < 256) *(LAS float*)(lds + RST_OFF + tid * 4) = row_rs((const GAS float*)g.rs_in, cur.pm * BM + tid);
        gd.rs_pm = cur.pm;
        asm volatile("s_waitcnt vmcnt(0) lgkmcnt(0)" ::: "memory"); __builtin_amdgcn_s_barrier(); asm volatile("" ::: "memory");
    }
    f32x4 acc[2][2][4][2];
#pragma unroll
    for (int a = 0; a < 2; ++a)
#pragma unroll
        for (int b = 0; b < 2; ++b)
#pragma unroll
            for (int m = 0; m < 4; ++m)
#pragma unroll
                for (int n = 0; n < 2; ++n) acc[a][b][m][n] = (f32x4){0.f, 0.f, 0.f, 0.f};
    bf16x8 At[4][2], B0[2][2], B1[2][2];
    const char* cA = cur.A; const char* cB = cur.B;
#if MK_SP2
    PG8_STAGE(PG8_SB(0, 0), cB, voffB); PG8_STAGE(PG8_SB(0, 1), cB + hstepB, voffB); PG8_STAGE(PG8_SA(0, 0), cA, voffA); PG8_STAGE(PG8_SA(0, 1), cA + hstepA, voffA);
    if (wr == 1) PG8_BAR;
    PG8_WAIT_V(2); PG8_BAR;
    PG8_STAGE(PG8_SB(1, 0), cB + kstep, voffB); PG8_STAGE(PG8_SA(1, 0), cA + kstep, voffA); PG8_STAGE(PG8_SB(1, 1), cB + hstepB + kstep, voffB);
    PG8_WAIT_V(6); PG8_BAR;
#else
    PG8_STAGE(PG8_SB(0, 0), cB, voffB); PG8_STAGE(PG8_SA(0, 0), cA, voffA); PG8_STAGE(PG8_SB(0, 1), cB + hstepB, voffB); PG8_STAGE(PG8_SA(0, 1), cA + hstepA, voffA);
    if (wr == 1) PG8_BAR;
    PG8_WAIT_V(4); PG8_BAR;
    PG8_STAGE(PG8_SB(1, 0), cB + kstep, voffB); PG8_STAGE(PG8_SA(1, 0), cA + kstep, voffA); PG8_STAGE(PG8_SB(1, 1), cB + hstepB + kstep, voffB);
    PG8_WAIT_V(6); PG8_BAR;
#endif
    for (;;) {
        const bool has_next = sched_next<MODE>(g, G, c, ui + 1, nxt);
        const char* nA = has_next ? nxt.A : cA; const char* nB = has_next ? nxt.B : cB;
        for (int t = 0; t < nt; t += 2) {
            const bool last = (t == nt - 2);
            const char* a1 = cA + (size_t)(t + 1) * kstep;
            const char* a2 = last ? nA : cA + (size_t)(t + 2) * kstep; const char* b2 = last ? nB : cB + (size_t)(t + 2) * kstep;
            const char* a3 = a2 + kstep; const char* b3 = b2 + kstep;
#if MK_SP2
            PG8_LDB(B0, 0, 0); PG8_LDB(B1, 0, 1); PG8_SCHED; PG8_LDA(At, 0, 0); PG8_STAGE(PG8_SA(1, 1), a1 + hstepA, voffA);
            PG8_WAIT_V(8); PG8_WAIT_L(0); PG8_BAR; PG8_MMA(0, 0, At, B0); PG8_MMA(0, 1, At, B1); PG8_BAR; PG8_SCHED;
            PG8_LDA(At, 0, 1); PG8_STAGE(PG8_SB(0, 0), b2, voffB); PG8_STAGE(PG8_SB(0, 1), b2 + hstepB, voffB); PG8_STAGE(PG8_SA(0, 0), a2, voffA);
            PG8_WAIT_V(8); PG8_WAIT_L(0); PG8_BAR; PG8_MMA(1, 0, At, B0); PG8_MMA(1, 1, At, B1); PG8_BAR; PG8_SCHED;
            PG8_LDB(B0, 1, 0); PG8_LDB(B1, 1, 1); PG8_SCHED; PG8_LDA(At, 1, 0); PG8_STAGE(PG8_SA(0, 1), a2 + hstepA, voffA);
            PG8_WAIT_V(8); PG8_WAIT_L(0); PG8_BAR; PG8_MMA(0, 0, At, B0); PG8_MMA(0, 1, At, B1); PG8_BAR; PG8_SCHED;
            PG8_LDA(At, 1, 1); PG8_STAGE(PG8_SB(1, 0), b3, voffB); PG8_STAGE(PG8_SB(1, 1), b3 + hstepB, voffB); PG8_STAGE(PG8_SA(1, 0), a3, voffA);
            PG8_WAIT_V(8); PG8_WAIT_L(0); PG8_BAR; PG8_MMA(1, 0, At, B0); PG8_MMA(1, 1, At, B1); PG8_BAR; PG8_SCHED;
#else
            PG8_LDB(B0, 0, 0); PG8_SCHED; PG8_LDA(At, 0, 0); PG8_STAGE(PG8_SA(1, 1), a1 + hstepA, voffA);
            PG8_WAIT_L(8); PG8_BAR; PG8_WAIT_L(0); PG8_MMA(0, 0, At, B0); PG8_BAR; PG8_SCHED;
            PG8_LDB(B1, 0, 1); PG8_STAGE(PG8_SB(0, 0), b2, voffB);
            PG8_BAR; PG8_WAIT_L(0); PG8_MMA(0, 1, At, B1); PG8_BAR;
            PG8_LDA(At, 0, 1); PG8_STAGE(PG8_SA(0, 0), a2, voffA);
            PG8_BAR; PG8_WAIT_L(0); PG8_MMA(1, 0, At, B0); PG8_BAR; PG8_SCHED;
            PG8_STAGE(PG8_SB(0, 1), b2 + hstepB, voffB);
            PG8_WAIT_V(6); PG8_BAR; PG8_MMA(1, 1, At, B1); PG8_BAR;
            PG8_LDB(B0, 1, 0); PG8_SCHED; PG8_LDA(At, 1, 0); PG8_STAGE(PG8_SA(0, 1), a2 + hstepA, voffA);
            PG8_WAIT_L(8); PG8_BAR; PG8_WAIT_L(0); PG8_MMA(0, 0, At, B0); PG8_BAR; PG8_SCHED;
            PG8_LDB(B1, 1, 1); PG8_STAGE(PG8_SB(1, 0), b3, voffB);
            PG8_BAR; PG8_WAIT_L(0); PG8_MMA(0, 1, At, B1); PG8_BAR;
            PG8_LDA(At, 1, 1); PG8_STAGE(PG8_SA(1, 0), a3, voffA);
            PG8_BAR; PG8_WAIT_L(0); PG8_MMA(1, 0, At, B0); PG8_BAR; PG8_SCHED;
            PG8_STAGE(PG8_SB(1, 1), b3 + hstepB, voffB);
            PG8_WAIT_V(6); PG8_BAR; PG8_MMA(1, 1, At, B1); PG8_BAR;
#endif
        }
        if (wr == 0) PG8_BAR;
        bool keep = false;
        if constexpr (MODE == GM_S1) break;
        else keep = epilogue<MODE>(gd, cur, acc, wr, wc, fr, fq);
        if (!has_next) break;
        if (!keep) {
#pragma unroll
            for (int a = 0; a < 2; ++a)
#pragma unroll
                for (int b = 0; b < 2; ++b)
#pragma unroll
                    for (int m = 0; m < 4; ++m)
#pragma unroll
                        for (int n = 0; n < 2; ++n) acc[a][b][m][n] = (f32x4){0.f, 0.f, 0.f, 0.f};
        }
        cur = nxt; cA = nA; cB = nB; ++ui;
        if (wr == 1) PG8_BAR;
    }
    PG8_WAIT_V(0);
    PG8_BAR; asm volatile("" ::: "memory");
    if constexpr (MODE == GM_S1) {
        LAS float* SL = (LAS float*)lds;
#pragma unroll
        for (int ai = 0; ai < 2; ++ai)
#pragma unroll
            for (int m = 0; m < 4; ++m) { LAS float* p = SL + (ai * HALF + wr * 64 + m * 16 + fr) * 128 + wc * 32 + 8 * fq; *(LAS f32x4*)p = acc[ai][0][m][0]; *(LAS f32x4*)(p + 4) = acc[ai][0][m][1]; }
        PG8_WAIT_L(0); PG8_BAR; asm volatile("" ::: "memory");
        if (tid < 128) {
            const int bb = tid >> 6, n = tid & 63, grp = cur.aux, b = 2 * cur.pm + bb;
            const GAS float* LAM = (const GAS float*)(g.ws + ws_lam(g.eb)) + (size_t)grp * 128; const float lr = LAM[2 * n], li = LAM[2 * n + 1];
            GAS bf16* XT = (GAS bf16*)(g.ws + WS_XS) + (size_t)(grp * NCHUNK + b * CPB) * XSK + 256 + n;
            const LAS float* Sp = SL + (bb * 128) * 128 + n;
            float hr = 0.f, hi = 0.f;
            for (int c0 = 0; c0 < CPB; c0 += 8) {
                float sr[8], si[8];
#pragma unroll
                for (int e = 0; e < 8; ++e) { sr[e] = Sp[(c0 + e) * 128]; si[e] = Sp[(c0 + e) * 128 + 64]; }
#pragma unroll
                for (int e = 0; e < 8; ++e) { XT[(size_t)(c0 + e) * XSK] = (bf16)f2bf(hr); XT[(size_t)(c0 + e) * XSK + 64] = (bf16)f2bf(hi);
                    const float nr = lr * hr - li * hi + sr[e], ni = lr * hi + li * hr + si[e]; hr = nr; hi = ni; }
            }
        }
        asm volatile("" ::: "memory"); PG8_BAR; asm volatile("" ::: "memory");
    }
#undef PG8_SA
#undef PG8_SB
#undef PG8_STAGE
#undef PG8_LDA
#undef PG8_LDB
#undef PG8_MMA
#undef PG8_WAIT_V
#undef PG8_WAIT_L
#undef PG8_BAR
#undef PG8_SCHED
}

typedef const GAS float* const __attribute__((address_space(4))) * KargPtr;
struct InTab { KargPtr kp; __device__ __forceinline__ const GAS float* operator[](int i) const { return (const GAS float*)kp[i]; } };
#define ARG_IN(i) (F.in[(i)])
struct Frame { LAS unsigned char* lds; int tid, lane, wave, vcu, G; InTab in; GAS float* out; GAS unsigned char* ws; };

constexpr int CW_DEP = 12288;
constexpr int CW_QUEUE = 8192;
static_assert((CW_DEP + 64 * 4 * DEPTH) * 4 <= (int)CTL_ZERO_BYTES && (CW_QUEUE + 64 * (1 + 2 * DEPTH)) <= CW_DEP && CW_BAR + XCD_BAR_WORDS <= CW_QUEUE, "control words inside the per-call memset");
__device__ __forceinline__ int queue_pull(Frame& F, int k) {
    volatile LAS int* slot = (volatile LAS int*)(F.lds + MISC_OFF + 64);
    __syncthreads();
    if (F.tid == 0) *slot = (int)__hip_atomic_fetch_add((unsigned*)(F.ws + WS_CTL) + CW_QUEUE + 64 * k, 1u, RLX_AGENT);
    __syncthreads();
    return *slot;
}
__device__ __forceinline__ float wave_sum(float v) {
#pragma unroll
    for (int o = 1; o < 64; o <<= 1) v += __shfl_xor(v, o);
    return v;
}
struct TItem { const GAS float* W; int ldw, col0, k0; const GAS float* gain; GAS bf16* dst; int ldd; };
__device__ __forceinline__ void titem_load(const TItem& t, f32x4 (&v)[8], int lane) {
    const int c4 = (lane & 7) * 4;
#pragma unroll
    for (int i = 0; i < 8; ++i) { const int kk = 8 * i + (lane >> 3); v[i] = *(const GAS f32x4*)(t.W + (size_t)(t.k0 + kk) * t.ldw + t.col0 + c4); }
}
__device__ __forceinline__ void titem_finish(const TItem& t, const f32x4 (&v)[8], LAS float* scr, int lane) {
    const int c4 = (lane & 7) * 4;
#pragma unroll
    for (int i = 0; i < 8; ++i) { const int kk = 8 * i + (lane >> 3); const float gn = t.gain ? t.gain[t.k0 + kk] : 1.0f; LAS float* p = scr + kk * 33 + c4;
        p[0] = v[i][0] * gn; p[1] = v[i][1] * gn; p[2] = v[i][2] * gn; p[3] = v[i][3] * gn; }
    LDS_WAIT(); asm volatile("" ::: "memory");
    const int c = lane & 7;
#pragma unroll
    for (int j = 0; j < 4; ++j) { const int n = (lane >> 3) + 8 * j; const LAS float* s = scr + (8 * c) * 33 + n;
        u32x4 o; o.x = pk2(s[0 * 33], s[1 * 33]); o.y = pk2(s[2 * 33], s[3 * 33]); o.z = pk2(s[4 * 33], s[5 * 33]); o.w = pk2(s[6 * 33], s[7 * 33]);
        *(GAS u32x4*)(t.dst + (size_t)n * t.ldd + t.k0 + 8 * c) = o; }
    LDS_WAIT(); asm volatile("" ::: "memory");
}
__device__ __forceinline__ void transpose_item(const GAS float* W, int ldw, int col0, int k0, const GAS float* gain, GAS bf16* dst, int ldd, LAS float* scr, int lane) {
    const TItem t{W, ldw, col0, k0, gain, dst, ldd}; f32x4 v[8]; titem_load(t, v, lane); titem_finish(t, v, scr, lane);
}

#if MK_PROBE
#define S5STAMP(k) do { if (blockIdx.x == 0 && threadIdx.x == 0 && l == 0) ((volatile LAS unsigned long long*)(F.lds + 132096))[k] = __builtin_amdgcn_s_memrealtime(); } while (0)
#else
#define S5STAMP(k) do {} while (0)
#endif
__device__ __forceinline__ void s5_group_prep(Frame& F, int l, int g) {
    LAS float* LPr = (LAS float*)F.lds;
    LAS float* LPi = LPr + 17 * 64;
    LAS float* BBr = LPi + 17 * 64;
    LAS float* BBi = BBr + 1024;
    LAS float* Cr = BBi + 1024;
    LAS float* Ci = Cr + 1024;
    LAS float* Kt = Ci + 1024;
    LAS float* Dk = Kt + 4096;
    const GAS float* a_re = F.in[4] + (size_t)(l * NG + g) * NS; const GAS float* a_im = F.in[5] + (size_t)(l * NG + g) * NS; const float log_dt = F.in[6][l * NG + g];
    const GAS float* b_re = F.in[7] + (size_t)(l * NG + g) * NS * NP; const GAS float* b_im = F.in[8] + (size_t)(l * NG + g) * NS * NP;
    const GAS float* c_re = F.in[9] + (size_t)(l * NG + g) * NP * NS; const GAS float* c_im = F.in[10] + (size_t)(l * NG + g) * NP * NS; const GAS float* dsk = F.in[11] + (size_t)(l * NG + g) * NP;
    const double dt = exp((double)log_dt);
    for (int idx = F.tid; idx < 17 * 64; idx += NTHR) { const int tau = idx >> 6, n = idx & 63;
        const double mag = exp((double)tau * dt * (double)a_re[n]), ang = (double)tau * dt * (double)a_im[n];
        const double angr = ang - 6.283185307179586476925 * rint(ang * 0.15915494309189533577);
        LPr[idx] = (float)(mag * (double)cosf((float)angr)); LPi[idx] = (float)(mag * (double)sinf((float)angr)); }
    for (int idx = F.tid; idx < 1024; idx += NTHR) { const int n = idx >> 4;
        const double ar = a_re[n], ai = a_im[n], mag = exp(dt * ar), ang = dt * ai, angr = ang - 6.283185307179586476925 * rint(ang * 0.15915494309189533577);
        const double abr = mag * (double)cosf((float)angr), abi = mag * (double)sinf((float)angr), den = ar * ar + ai * ai, nr = abr - 1.0, ni = abi;
        const double fr = (nr * ar + ni * ai) / den, fi = (ni * ar - nr * ai) / den, br = b_re[idx], bi = b_im[idx];
        BBr[idx] = (float)(fr * br - fi * bi); BBi[idx] = (float)(fr * bi + fi * br);
        Cr[idx] = c_re[idx]; Ci[idx] = c_im[idx]; }
    if (F.tid < 16) Dk[F.tid] = dsk[F.tid];
    __syncthreads();
    { const int tau = F.tid >> 5, q = (F.tid >> 1) & 15, p0 = (F.tid & 1) * 8; float kr[8];
#pragma unroll
      for (int e = 0; e < 8; ++e) kr[e] = 0.f;
#pragma unroll 4
      for (int n = 0; n < 64; ++n) { const float cr = Cr[q * 64 + n], ci = Ci[q * 64 + n], lr = LPr[tau * 64 + n], li = LPi[tau * 64 + n], xr = cr * lr - ci * li, xi = cr * li + ci * lr;
          const f32x4 br0 = *(const LAS f32x4*)(BBr + n * 16 + p0), br1 = *(const LAS f32x4*)(BBr + n * 16 + p0 + 4), bi0 = *(const LAS f32x4*)(BBi + n * 16 + p0), bi1 = *(const LAS f32x4*)(BBi + n * 16 + p0 + 4);
#pragma unroll
          for (int e = 0; e < 4; ++e) { kr[e] += xr * br0[e] - xi * bi0[e]; kr[4 + e] += xr * br1[e] - xi * bi1[e]; } }
#pragma unroll
      for (int e = 0; e < 8; ++e) Kt[(tau * 16 + q) * 16 + p0 + e] = kr[e]; }
    __syncthreads();
    const int eb = l & 1;
    GAS bf16* TW = (GAS bf16*)(F.ws + ws_e(eb) + EO_TW) + (size_t)g * 256 * XSK;
    for (int pc = F.tid; pc < 256 * 32; pc += NTHR) { const int row = pc >> 5, k8 = (pc & 31) * 8, i = row >> 4, q = row & 15, j = k8 >> 4, p0 = k8 & 15;
        const int tau = (i - j) > 0 ? (i - j) : 0; const LAS float* kp = Kt + (tau * 16 + q) * 16 + p0;
        f32x4 v0 = *(const LAS f32x4*)kp, v1 = *(const LAS f32x4*)(kp + 4);
        const float dq = Dk[q]; const int dpos = (i == j) ? q - p0 : -1;
#pragma unroll
        for (int e = 0; e < 4; ++e) { v0[e] = (j <= i) ? v0[e] + (dpos == e ? dq : 0.f) : 0.f; v1[e] = (j <= i) ? v1[e] + (dpos == 4 + e ? dq : 0.f) : 0.f; }
        u32x4 o; o.x = pk2(v0[0], v0[1]); o.y = pk2(v0[2], v0[3]); o.z = pk2(v1[0], v1[1]); o.w = pk2(v1[2], v1[3]);
        *(GAS u32x4*)(TW + (size_t)row * XSK + k8) = o; }
    for (int pc = F.tid; pc < 256 * 16; pc += NTHR) { const int row = pc >> 4, kk = (pc & 15) * 8, i = row >> 4, q = row & 15, part = kk >> 6, n0 = kk & 63;
        const f32x4 cr0 = *(const LAS f32x4*)(Cr + q * 64 + n0), cr1 = *(const LAS f32x4*)(Cr + q * 64 + n0 + 4), ci0 = *(const LAS f32x4*)(Ci + q * 64 + n0), ci1 = *(const LAS f32x4*)(Ci + q * 64 + n0 + 4);
        const f32x4 lr0 = *(const LAS f32x4*)(LPr + (i + 1) * 64 + n0), lr1 = *(const LAS f32x4*)(LPr + (i + 1) * 64 + n0 + 4), li0 = *(const LAS f32x4*)(LPi + (i + 1) * 64 + n0), li1 = *(const LAS f32x4*)(LPi + (i + 1) * 64 + n0 + 4);
        const f32x4 v0 = part == 0 ? (cr0 * lr0 - ci0 * li0) : -(cr0 * li0 + ci0 * lr0), v1 = part == 0 ? (cr1 * lr1 - ci1 * li1) : -(cr1 * li1 + ci1 * lr1);
        u32x4 o; o.x = pk2(v0[0], v0[1]); o.y = pk2(v0[2], v0[3]); o.z = pk2(v1[0], v1[1]); o.w = pk2(v1[2], v1[3]);
        *(GAS u32x4*)(TW + (size_t)row * XSK + 256 + kk) = o; }
    GAS bf16* WS = (GAS bf16*)(F.ws + ws_e(eb) + EO_WS) + (size_t)g * 256 * 256;
    for (int pc = F.tid; pc < 256 * 32; pc += NTHR) { const int row = pc >> 5, k8 = (pc & 31) * 8, j = k8 >> 4, p0 = k8 & 15, n = row & 63;
        const float lr = LPr[(15 - j) * 64 + n], li = LPi[(15 - j) * 64 + n];
        const f32x4 br0 = *(const LAS f32x4*)(BBr + n * 16 + p0), br1 = *(const LAS f32x4*)(BBr + n * 16 + p0 + 4), bi0 = *(const LAS f32x4*)(BBi + n * 16 + p0), bi1 = *(const LAS f32x4*)(BBi + n * 16 + p0 + 4);
        f32x4 v0 = row < 64 ? (br0 * lr - bi0 * li) : (bi0 * lr + br0 * li), v1 = row < 64 ? (br1 * lr - bi1 * li) : (bi1 * lr + br1 * li);
        if (row >= 128) { v0 = (f32x4){0.f, 0.f, 0.f, 0.f}; v1 = v0; }
        u32x4 o; o.x = pk2(v0[0], v0[1]); o.y = pk2(v0[2], v0[3]); o.z = pk2(v1[0], v1[1]); o.w = pk2(v1[2], v1[3]);
        *(GAS u32x4*)(WS + (size_t)row * 256 + k8) = o; }
    GAS float* LAM = (GAS float*)(F.ws + ws_lam(eb)) + (size_t)g * 128;
    if (F.tid < 64) { LAM[F.tid * 2] = LPr[16 * 64 + F.tid]; LAM[F.tid * 2 + 1] = LPi[16 * 64 + F.tid]; }
    __syncthreads();
}

__device__ __forceinline__ void pool_fold_item(Frame& F, int l, int item) {
    const int kk = item >> 4, k0 = (item & 15) * 64;
    LAS float* Wi = (LAS float*)F.lds;
    LAS float* Wg = Wi + 64 * 129;
    LAS bf16* To = (LAS bf16*)(Wg + 128 * 128);
    const GAS float* w_in = F.in[2] + (size_t)l * DM * INW; const GAS float* wgrp = F.in[20] + (size_t)(l * 4 + kk) * PGW * PGW; const GAS float* norm1 = F.in[1] + (size_t)l * DM;
    {
        f32x4 wi[4], wg[8];
#pragma unroll
        for (int j = 0; j < 4; ++j) { const int i4 = F.tid + j * NTHR, r = i4 >> 5, c4 = (i4 & 31) * 4; wi[j] = *(const GAS f32x4*)(w_in + (size_t)(k0 + r) * INW + 1536 + kk * PGW + c4); }
#pragma unroll
        for (int j = 0; j < 8; ++j) wg[j] = *(const GAS f32x4*)(wgrp + (size_t)(F.tid + j * NTHR) * 4);
#pragma unroll
        for (int j = 0; j < 4; ++j) { const int i4 = F.tid + j * NTHR, r = i4 >> 5, c4 = (i4 & 31) * 4; LAS float* p = Wi + r * 129 + c4; p[0] = wi[j][0]; p[1] = wi[j][1]; p[2] = wi[j][2]; p[3] = wi[j][3]; }
#pragma unroll
        for (int j = 0; j < 8; ++j) *(LAS f32x4*)(Wg + (F.tid + j * NTHR) * 4) = wg[j];
    }
    __syncthreads();
    const int k = F.tid >> 3, jg = F.tid & 7; float acc[16];
#pragma unroll
    for (int e = 0; e < 16; ++e) acc[e] = 0.f;
    for (int i = 0; i < 128; ++i) { const float a = Wi[k * 129 + i];
#pragma unroll
        for (int e = 0; e < 16; ++e) acc[e] += a * Wg[i * 128 + jg * 16 + e]; }
    const float gn = norm1[k0 + k];
#pragma unroll
    for (int e = 0; e < 16; ++e) To[(jg * 16 + e) * 72 + k] = (bf16)f2bf(acc[e] * gn);
    __syncthreads();
    GAS bf16* dst = (GAS bf16*)(F.ws + ws_e(l & 1) + EO_WMIX) + (size_t)(1536 + kk * PGW) * DM + k0;
    for (int pc = F.tid; pc < 128 * 8; pc += NTHR) { const int j = pc >> 3, c8 = (pc & 7) * 8; *(GAS u32x4*)(dst + (size_t)j * DM + c8) = *(const LAS u32x4*)(To + j * 72 + c8); }
    __syncthreads();
}

__device__ __forceinline__ void convert_E_waves(Frame& F, int l, int w, int NW, int it_lo, int it_hi) {
    const InTab in = F.in; const int eb = l & 1;
    LAS float* scr = (LAS float*)(F.lds + F.wave * 16384);
    const GAS float* norm1 = in[1] + (size_t)l * DM; const GAS float* w_in = in[2] + (size_t)l * DM * INW;
    constexpr int R1 = 768, R2 = R1 + 128, R3 = R2 + 16;
    if (it_hi > R3) it_hi = R3;
    for (int it = it_lo + w; it < it_hi; it += NW) {
        if (it < R1) {
            const int blk = it >> 6, r = it & 63, kb = r >> 2, nb = r & 3;
            int col0; if (blk < 4) col0 = blk * 128; else { const int t = (blk - 4) >> 1, gt = (blk - 4) & 1; col0 = 512 + gt * 512 + t * 128; }
            transpose_item(w_in, INW, col0 + nb * 32, kb * 64, norm1, (GAS bf16*)(F.ws + ws_e(eb) + EO_WMIX) + (size_t)(blk * 128 + nb * 32) * DM, DM, scr, F.lane);
        } else if (it < R2) { const int r = it - R1, blk = r >> 5, q = r & 31, kb = q >> 2, nb = q & 3;
            transpose_item(in[12] + (size_t)l * SW * SW, SW, blk * 128 + nb * 32, kb * 64, nullptr, (GAS bf16*)(F.ws + ws_e(eb) + EO_WGLU) + (size_t)(blk * 128 + nb * 32) * SW, SW, scr, F.lane);
        } else {
            const GAS float* wdw = in[15] + (size_t)l * CKW * CW; GAS float* cwt = (GAS float*)(F.ws + ws_cwt(eb));
            for (int j = F.lane; j < 1024; j += 64) { const int i = (it - R2) * 1024 + j, cpair = i >> 6, k = (i >> 1) & 31, e = i & 1; cwt[i] = (k < CKW) ? wdw[k * CW + 2 * cpair + e] : 0.f; }
        }
    }
}
__device__ __forceinline__ TItem l_item(Frame& F, int l, int it) {
    const InTab in = F.in;
    constexpr int R2 = 1536, R4 = R2 + 768, R5 = R4 + 512, R6 = R5 + 2816, R7 = R6 + 1408; static_assert(R7 == 7040, "late-set items");
    if (it < R2) { const int blk = it >> 6, q = it & 63, kb = q >> 2, nb = q & 3;
        return TItem{in[2] + (size_t)l * DM * INW, INW, 2048 + blk * 128 + nb * 32, kb * 64, in[1] + (size_t)l * DM, (GAS bf16*)(F.ws + WS_WGATE) + (size_t)(blk * 128 + nb * 32) * DM, DM}; }
    if (it < R4) { const int r = it - R2, src = r >> 8, r2 = r & 255, blk = r2 >> 5, q = r2 & 31, kb = q >> 2, nb = q & 3;
        return TItem{(src == 0 ? in[14] : src == 1 ? in[19] : in[22]) + (size_t)l * 512 * DM, DM, blk * 128 + nb * 32, kb * 64, nullptr, (GAS bf16*)(F.ws + WS_WBR) + (size_t)(blk * 128 + nb * 32) * 1536 + src * 512, 1536}; }
    if (it < R5) { const int r = it - R4, blk = r >> 6, q = r & 63, kb = q >> 2, nb = q & 3;
        return TItem{in[23] + (size_t)l * DM * DM, DM, blk * 128 + nb * 32, kb * 64, nullptr, (GAS bf16*)(F.ws + WS_WOUT) + (size_t)(blk * 128 + nb * 32) * DM, DM}; }
    if (it < R6) { const int r = it - R5, blk = r >> 6, q = r & 63, kb = q >> 2, nb = q & 3;
        return TItem{((blk & 1) ? in[26] : in[25]) + (size_t)l * DM * FF, FF, (blk >> 1) * 128 + nb * 32, kb * 64, in[24] + (size_t)l * DM, (GAS bf16*)(F.ws + WS_WGU) + (size_t)(blk * 128 + nb * 32) * DM, DM}; }
    { const int r = it - R6, blk = r / 176, q = r % 176, kb = q >> 2, nb = q & 3;
        return TItem{in[27] + (size_t)l * FF * DM, DM, blk * 128 + nb * 32, kb * 64, nullptr, (GAS bf16*)(F.ws + WS_WDN) + (size_t)(blk * 128 + nb * 32) * FF, FF}; }
}
__device__ __forceinline__ void convert_L_waves(Frame& F, int l, int w, int NW, int it_lo, int it_hi) {
    LAS float* scr = (LAS float*)(F.lds + F.wave * 16384);
    int it = it_lo + w; if (it >= it_hi) return;
    TItem ta = l_item(F, l, it), tb = ta; f32x4 va[8], vb[8];
    titem_load(ta, va, F.lane);
    for (;;) {
        const int i1 = it + NW; const bool h1 = i1 < it_hi;
        if (h1) { tb = l_item(F, l, i1); titem_load(tb, vb, F.lane); }
        titem_finish(ta, va, scr, F.lane);
        if (!h1) break;
        const int i2 = i1 + NW; const bool h2 = i2 < it_hi;
        if (h2) { ta = l_item(F, l, i2); titem_load(ta, va, F.lane); }
        titem_finish(tb, vb, scr, F.lane);
        if (!h2) break;
        it = i2;
    }
}
__device__ __forceinline__ void xb0_waves(Frame& F, int w, int NW, int m_lo, int m_hi) {
    GAS float* rsa = (GAS float*)(F.ws + WS_RSA); GAS bf16* XB = (GAS bf16*)(F.ws + WS_XB); const GAS float* x = F.in[0];
    for (int m = m_lo + w; m < m_hi; m += NW) {
        const GAS f32x4* xr = (const GAS f32x4*)(x + (size_t)m * DM) + F.lane; f32x4 v[4]; float s = 0.f;
#pragma unroll
        for (int j = 0; j < 4; ++j) { v[j] = xr[64 * j]; s += (v[j].x * v[j].x + v[j].y * v[j].y) + (v[j].z * v[j].z + v[j].w * v[j].w); }
        s = wave_sum(s);
        GAS unsigned long long* o8 = (GAS unsigned long long*)(XB + (size_t)m * DM) + F.lane;
#pragma unroll
        for (int j = 0; j < 4; ++j) o8[64 * j] = (unsigned long long)pk2(v[j].x, v[j].y) | ((unsigned long long)pk2(v[j].z, v[j].w) << 32);
        if (F.lane < 4) *(GAS f32x4*)(rsa + (size_t)F.lane * (4 * M) + (size_t)m * 4) = (f32x4){F.lane == 0 ? s : 0.f, 0.f, 0.f, 0.f};
    }
}

template <int W> __device__ __forceinline__ void pool_regs(const unsigned (&vr)[47], GAS bf16* brp, int s_first, f32x2 sc) {
    float sm0 = 0.f, sm1 = 0.f;
#pragma unroll
    for (int tau = 1; tau < W; ++tau) { sm0 += bf_lo(vr[15 - tau]); sm1 += bf_hi(vr[15 - tau]); }
#pragma unroll
    for (int i = 0; i < 32; ++i) { const float v0 = bf_lo(vr[15 + i]), v1 = bf_hi(vr[15 + i]);
        sm0 += v0; sm1 += v1;
        const int pos = s_first + i + 1; const float inv = 1.0f / (float)(pos < W ? pos : W);
        *(GAS unsigned*)(brp + (size_t)i * 1536) = pk2(sc.x * (sm0 * inv - v0), sc.y * (sm1 * inv - v1));
        sm0 -= bf_lo(vr[15 + i - (W - 1)]); sm1 -= bf_hi(vr[15 + i - (W - 1)]); }
}
__device__ __forceinline__ void mixer_tile(Frame& F, int l, int tile) {
    const int t0 = tile * 64, s0 = t0 & (SEQ - 1);
    const GAS bf16* HC = (const GAS bf16*)(F.ws + WS_HC); const GAS bf16* V = (const GAS bf16*)(F.ws + WS_V); GAS bf16* BR = (GAS bf16*)(F.ws + WS_BR);
    LAS unsigned char* hb = F.lds;
    LAS f32x2* part = (LAS f32x2*)(F.lds + 98304);
    LAS f32x2* stat = (LAS f32x2*)(F.lds + RST_OFF + 1024);
    for (int r = F.wave; r < 94; r += NWAVES) {
        if (s0 - 30 + r >= 0) __builtin_amdgcn_global_load_lds((const GAS unsigned*)(HC + (size_t)(t0 - 30 + r) * CW + F.lane * 8), (LAS unsigned*)(hb + r * 1024), 16, 0, 0);
        else { unsigned z = 0u; asm volatile("" : "+v"(z)); *(LAS u32x4*)(hb + r * 1024 + F.lane * 16) = (u32x4){z, z, z, z}; }
    }
    const int cp = F.tid & 255, th = F.tid >> 8;
    unsigned vr[47];
#pragma unroll
    for (int r = 0; r < 47; ++r) { const int tl = th * 32 - 15 + r; vr[r] = *(const GAS unsigned*)(V + (size_t)(t0 + (s0 + tl >= 0 ? tl : -s0)) * PW + 2 * cp); }
    f32x2 wt[32];
    { const GAS f32x4* wp = (const GAS f32x4*)((const GAS float*)(F.ws + ws_cwt(l & 1)) + (size_t)cp * 64);
#pragma unroll
      for (int k2 = 0; k2 < 16; ++k2) { const f32x4 a = wp[k2]; wt[2 * k2] = (f32x2){a[0], a[1]}; wt[2 * k2 + 1] = (f32x2){a[2], a[3]}; } }
    const f32x2 bdw = *(const GAS f32x2*)(F.in[16] + (size_t)l * CW + 2 * cp);
    const f32x2 lng = *(const GAS f32x2*)(F.in[17] + (size_t)l * CW + 2 * cp), lnb = *(const GAS f32x2*)(F.in[18] + (size_t)l * CW + 2 * cp);
    VM_WAIT(); __syncthreads();
#pragma unroll 1
    for (int rr = 0; rr < 4; ++rr) {
        const int tb = (th * 4 + rr) * 8;
        f32x2 a[8];
#pragma unroll
        for (int i = 0; i < 8; ++i) a[i] = bdw;
#pragma unroll
        for (int r = 0; r < 38; ++r) { const unsigned w = *(const LAS unsigned*)(hb + (tb + r) * 1024 + cp * 4); const f32x2 h = (f32x2){bf_lo(w), bf_hi(w)};
#pragma unroll
            for (int i = 0; i < 8; ++i) { const int k = r - i; if (k >= 0 && k < CKW) a[i] += wt[k] * h; } }
#pragma unroll
        for (int i = 0; i < 8; ++i) part[(th * 8 + i) * 256 + cp] = (f32x2){a[i].x + a[i].y, a[i].x * a[i].x + a[i].y * a[i].y};
        __syncthreads();
        { const int tk = F.tid >> 5, sg = F.tid & 31; f32x2 p = part[tk * 256 + sg];
#pragma unroll
          for (int e = 1; e < 8; ++e) p += part[tk * 256 + sg + 32 * e];
#pragma unroll
          for (int o = 1; o < 32; o <<= 1) { p.x += __shfl_xor(p.x, o); p.y += __shfl_xor(p.y, o); }
          if (sg == 0) { const float mu = p.x * (1.0f / CW), var = p.y * (1.0f / CW) - mu * mu; stat[tk] = (f32x2){mu, __builtin_amdgcn_rsqf(fmaxf(var, 0.f) + EPS)}; } }
        __syncthreads();
#pragma unroll
        for (int i = 0; i < 8; ++i) { const int tok = tb + i; const f32x2 st = stat[th * 8 + i];
            float y0 = (a[i].x - st.x) * st.y * lng.x + lnb.x, y1 = (a[i].y - st.x) * st.y * lng.y + lnb.y; y0 *= fsigmoid(y0); y1 *= fsigmoid(y1);
            *(GAS unsigned*)(BR + (size_t)(t0 + tok) * 1536 + 512 + 2 * cp) = pk2(y0, y1); }
    }
    {
        const f32x2 sc = *(const GAS f32x2*)(F.in[21] + (size_t)l * PW + 2 * cp); GAS bf16* brp = BR + (size_t)(t0 + th * 32) * 1536 + 1024 + 2 * cp; const int sf = s0 + th * 32;
#pragma unroll
        for (int r = 0; r < 15; ++r) if (sf - 15 + r < 0) vr[r] = 0u;
        switch (cp >> 6) { case 0: pool_regs<2>(vr, brp, sf, sc); break; case 1: pool_regs<4>(vr, brp, sf, sc); break; case 2: pool_regs<8>(vr, brp, sf, sc); break; default: pool_regs<16>(vr, brp, sf, sc); break; }
    }
    __syncthreads();
}

__device__ __forceinline__ void final_phase(Frame& F) {
    const GAS float* rsa = (const GAS float*)(F.ws + WS_RSA); const GAS float* gfin = F.in[28]; const GAS bf16* XB = (const GAS bf16*)(F.ws + WS_XB);
    const int gw = F.vcu * NWAVES + F.wave, NGW = F.G * NWAVES;
    for (int m = gw; m < M; m += NGW) { const float rs = row_rs(rsa, m);
        GAS f32x4* o = (GAS f32x4*)(F.out + (size_t)m * DM); const GAS f32x4* gr = (const GAS f32x4*)gfin;
#pragma unroll
        for (int j = 0; j < 2; ++j) { const int c8 = j * 64 + F.lane; const u32x4 w = *(const GAS u32x4*)(XB + (size_t)m * DM + c8 * 8);
            const f32x4 x0 = (f32x4){bf_lo(w.x), bf_hi(w.x), bf_lo(w.y), bf_hi(w.y)}, x1 = (f32x4){bf_lo(w.z), bf_hi(w.z), bf_lo(w.w), bf_hi(w.w)};
            o[c8 * 2] = x0 * rs * gr[c8 * 2]; o[c8 * 2 + 1] = x1 * rs * gr[c8 * 2 + 1]; } }
}

constexpr int PH_PER_LAYER = 6, PH_FINAL = 1 + PH_PER_LAYER * DEPTH, PH_TOTAL = PH_FINAL + 1;
__global__ void __launch_bounds__(NTHR, 2) mk_fwd(Args args) {
    extern __shared__ __attribute__((aligned(16))) unsigned char lds_raw[];
    Frame F; F.lds = (LAS unsigned char*)lds_raw; F.tid = threadIdx.x; F.lane = F.tid & 63; F.wave = __builtin_amdgcn_readfirstlane(F.tid >> 6);
    F.G = gridDim.x; { const int bx = blockIdx.x; F.vcu = (F.G % 8 == 0) ? (bx % 8) * (F.G / 8) + bx / 8 : bx; }
    F.out = (GAS float*)args.out; F.ws = (GAS unsigned char*)args.ws;
    unsigned char* ws = args.ws;
    volatile LAS unsigned* MISC = (volatile LAS unsigned*)(F.lds + MISC_OFF);
    for (int u = F.tid; u < (LDS_BYTES - LDSCTL_OFF) / 4; u += NTHR) ((LAS unsigned*)(F.lds + LDSCTL_OFF))[u] = 0u;
    __syncthreads();
    XcdBarrier bar; bar.bar = (unsigned*)(ws + WS_CTL) + CW_BAR; bar.x = 0; bar.st = nullptr;
    const bool multi = (args.ph_hi - args.ph_lo) > 1;
    if (multi) bar = xcd_barrier_post((unsigned*)(ws + WS_CTL) + CW_BAR, MISC + 8);
    const int wave0 = F.wave, vcu0 = F.vcu, G0 = F.G;
#if MK_PROBE
    PSTAMP(args.ph_lo);
#endif
    for (int ph = args.ph_lo; ph < args.ph_hi; ++ph) {
        { int wv_ = wave0, vc_ = vcu0, g_ = G0; asm volatile("" : "+s"(wv_), "+s"(vc_), "+s"(g_)); F.wave = wv_; F.vcu = vc_; F.G = g_;
          int l_ = (int)__builtin_amdgcn_mbcnt_hi(~0u, __builtin_amdgcn_mbcnt_lo(~0u, 0u)); asm volatile("" : "+v"(l_)); F.lane = l_; F.tid = F.wave * 64 + l_;
          unsigned char* w_ = args.ws; asm volatile("" : "+s"(w_)); ws = as_global(w_); F.ws = (GAS unsigned char*)w_; F.out = (GAS float*)args.out;
          KargPtr k_ = (KargPtr)__builtin_amdgcn_kernarg_segment_ptr(); asm volatile("" : "+s"(k_)); F.in.kp = k_; }
        int cblk = (int)blockIdx.x; asm volatile("" : "+s"(cblk));
        const int l = (ph - 1) / PH_PER_LAYER, pt = (ph - 1) - l * PH_PER_LAYER, eb = l & 1;
        if (ph == PH_FINAL) final_phase(F);
        else if (ph != 0) {
            GDesc d; d.ws = ws; d.mode = 0; d.nM = M / BM; d.nN = 1; d.rs_in = nullptr; d.rs_out = nullptr; d.bias = nullptr; d.xold = nullptr; d.xnew = nullptr; d.xb = nullptr; d.xres = nullptr; d.lds = F.lds; d.rs_pm = -1; d.eb = eb; d.blk = cblk;
            float* rsa = (float*)(ws + WS_RSA); float* rsb = (float*)(ws + WS_RSB);
            unsigned char* we = ws + ws_e(eb);
            switch (pt) {
            case 0: d.A = (const char*)(ws + WS_XB); d.B = (const char*)(we + EO_WMIX); d.lda = DM; d.ldb = DM; d.K = DM; d.nN = 8; d.rs_in = rsa;
                    gemm_phase<GM_MIX>(F.lds, d, F.G, cblk, F.wave); break;
            case 1: if (cblk < 128) {
                        d.A = (const char*)(ws + WS_XS); d.B = (const char*)(we + EO_WS); d.lda = XSK; d.ldb = 256; d.K = 256;
                        gemm_phase<GM_S1>(F.lds, d, F.G, cblk, F.wave);
                        asm volatile("s_waitcnt vmcnt(0)" ::: "memory"); __syncthreads();
                        d.B = (const char*)(we + EO_TW); d.ldb = XSK; d.K = XSK;
                        gemm_phase<GM_S3>(F.lds, d, F.G, cblk, F.wave);
                        asm volatile("s_waitcnt vmcnt(0)" ::: "memory"); __syncthreads();
                        if (F.tid == 0) {
                            unsigned* dep = (unsigned*)(ws + WS_CTL) + CW_DEP + 64 * (4 * l);
                            __builtin_amdgcn_fence(__ATOMIC_RELEASE, "agent"); asm volatile("s_waitcnt vmcnt(0)" ::: "memory");
                            __hip_atomic_fetch_add(dep + 64 * (cblk & 3), 1u, RLX_AGENT);
                            const int pmg = 8 * (cblk & 7) + ((cblk >> 3) & 7); unsigned sp = 0;
                            while (__hip_atomic_load(dep + 64 * (pmg >> 4), RLX_AGENT) < 32u) { __builtin_amdgcn_s_sleep(2); if (++sp > (1u << 22)) break; }
                            __builtin_amdgcn_fence(__ATOMIC_ACQUIRE, "agent"); asm volatile("s_waitcnt vmcnt(0)" ::: "memory");
                        }
                        __syncthreads();
                        d.A = (const char*)(ws + WS_YS); d.B = (const char*)(we + EO_WGLU); d.lda = SW; d.ldb = SW; d.K = SW; d.nN = 2; d.bias = (const float*)(ARG_IN(13) + (size_t)l * SW);
                        gemm_phase<GM_GLU>(F.lds, d, F.G, cblk, F.wave);
                    }
                    break;
            case 2: d.A = (const char*)(ws + WS_XB); d.B = (const char*)(ws + WS_WGATE); d.lda = DM; d.ldb = DM; d.K = DM; d.nN = 12; d.rs_in = rsa; d.bias = (const float*)(ARG_IN(3) + (size_t)l * 3 * DM);
                    if (l == 0) PSTAMP(36);
                    gemm_phase<GM_GATE>(F.lds, d, F.G, cblk, F.wave);
                    asm volatile("s_waitcnt vmcnt(0)" ::: "memory"); __syncthreads();
                    if (l == 0) PSTAMP(37);
                    d.A = (const char*)(ws + WS_BR); d.B = (const char*)(ws + WS_WBR); d.lda = 1536; d.ldb = 1536; d.K = 512; d.nN = 4; d.rs_in = nullptr; d.bias = nullptr;
                    d.xb = (bf16*)F.out;
                    gemm_phase<GM_MERGE>(F.lds, d, F.G, cblk, F.wave); break;
            case 3: d.A = (const char*)F.out; d.B = (const char*)(ws + WS_WOUT); d.lda = DM; d.ldb = DM; d.K = DM; d.nN = 4;
                    d.xold = nullptr; d.xres = (const bf16*)(ws + WS_XB); d.xnew = nullptr; d.xb = (bf16*)(ws + WS_XB2); d.rs_out = rsb;
                    gemm_phase<GM_WOUT>(F.lds, d, F.G, cblk, F.wave); break;
            case 4: d.A = (const char*)(ws + WS_XB2); d.B = (const char*)(ws + WS_WGU); d.lda = DM; d.ldb = DM; d.K = DM; d.nN = 22; d.rs_in = rsb;
                    gemm_phase<GM_GU>(F.lds, d, F.G, cblk, F.wave); break;
            default: d.A = (const char*)(ws + WS_HID); d.B = (const char*)(ws + WS_WDN); d.lda = FF; d.ldb = FF; d.K = FF; d.nN = 4;
                    d.xold = nullptr; d.xres = (const bf16*)(ws + WS_XB2); d.xnew = nullptr; d.xb = (bf16*)(ws + WS_XB); d.rs_out = rsa;
                    gemm_phase<GM_WOUT>(F.lds, d, F.G, cblk, F.wave); break;
            }
        }
        const bool qg = (ph != 0 && ph != PH_FINAL && pt == 4 && l + 1 < DEPTH);
        if (ph == 0 || (ph != PH_FINAL && pt == 1) || qg) {
            const bool ce = (ph == 0) || qg;
            const int cl = (ph == 0) ? 0 : l + 1, ll = qg ? l + 1 : l, qk = (ph == 0) ? 0 : (qg ? 1 + DEPTH + l : 1 + l);
            const int llo = qg ? 0 : ((ph != 0 && l > 0) ? 176 : 0), lhi = qg ? 176 : 440;
            const int nS = ce ? 32 : 0, nM = (ph != 0 && !qg) ? 256 : 0, nP = ce ? 64 : 0, nE = ce ? 57 : 0, nL = (ph == 0) ? 0 : lhi - llo, nX = (ph == 0) ? 512 : 0;
            const int m0 = nS, p0 = m0 + nM, e0 = p0 + nP, l0 = e0 + nE, x0 = l0 + nL, tot = x0 + nX;
            for (;;) { const int it = queue_pull(F, qk); if (it >= tot) break;
                { int l_ = F.lane; asm volatile("" : "+v"(l_)); F.lane = l_; F.tid = F.wave * 64 + l_; }
                if (it < nS) s5_group_prep(F, cl, it);
                else if (it < p0) mixer_tile(F, l, it - m0);
                else if (it < e0) pool_fold_item(F, cl, it - p0);
                else if (it < l0) convert_E_waves(F, cl, F.wave, NWAVES, (it - e0) * 16, (it - e0) * 16 + 16);
                else if (it < x0) convert_L_waves(F, ll, F.wave, NWAVES, (llo + it - l0) * 16, (llo + it - l0) * 16 + 16);
                else xb0_waves(F, F.wave, NWAVES, (it - x0) * 32, (it - x0) * 32 + 32);
            }
        }
        if (ph + 1 < args.ph_hi) xcd_barrier(bar);
#if MK_PROBE
        if (ph == 5 && multi) { PSTAMP(41); xcd_barrier(bar); PSTAMP(42); xcd_barrier(bar); PSTAMP(43); }
#endif
#if MK_PROBE
        PSTAMP(ph + 1);
#endif
    }
#if MK_PROBE
    if (blockIdx.x == PROBE_BLK && threadIdx.x == 0) {
        volatile LAS unsigned long long* st = (volatile LAS unsigned long long*)(F.lds + 132096);
        unsigned long long qa = (st[PROBE_A + 1] - st[PROBE_A]) / 400ull, qb = (st[PROBE_B + 1] - st[PROBE_B]) / 400ull; if (qa > 127) qa = 127; if (qb > 127) qb = 127;
        const unsigned long long t0 = __builtin_amdgcn_s_memrealtime(), dl = 1000ull * (qa + 128ull * qb);
        while (__builtin_amdgcn_s_memrealtime() - t0 < dl) __builtin_amdgcn_s_sleep(8);
    }
#endif
}


#if MK_DIAG
__global__ void diag_sum(const unsigned* o, size_t nwords, unsigned* acc) {
    unsigned cs = 0; for (size_t i = (size_t)blockIdx.x * blockDim.x + threadIdx.x; i < nwords; i += (size_t)gridDim.x * blockDim.x) cs += o[i] * 2654435761u + (unsigned)i;
    for (int k = 1; k < 64; k <<= 1) cs += __shfl_xor(cs, k);
    if ((threadIdx.x & 63) == 0) atomicAdd(acc, cs);
}
__global__ void diag_cmp(float* out, const unsigned* acc, unsigned* pers, const unsigned* tmo) {
    const unsigned total = *acc, magic = pers[0], prev = pers[1], sticky = pers[2];
    const bool mism = (magic == 0x600DF00Du && (sticky == 1u || prev != total));
    const bool bad = (DIAG_WHAT == 0) ? (*tmo != 0u) : mism;
    __syncthreads();
    if (threadIdx.x == 0) { pers[0] = 0x600DF00Du; pers[1] = total; pers[2] = mism ? 1u : 0u; }
    if (bad) for (int i = threadIdx.x; i < 4096; i += blockDim.x) out[i] = __builtin_nanf("");
}
#endif
extern "C" void kernel_launch(void* const* d_in, const int* in_sizes, int n_in, void* d_out, int out_size, void* d_ws, size_t ws_size, hipStream_t stream) {
    static int grid = 0;
    if (grid == 0) {
        if (n_in != 29 || out_size != M * DM || ws_size < WS_END) { fprintf(stderr, "kernel_launch: unexpected shapes (n_in %d out %d ws %zu)\n", n_in, out_size, ws_size); grid = -1; return; }
        int dev = 0, cus = 0, per_cu = 0;
        if (hipGetDevice(&dev) != hipSuccess || hipDeviceGetAttribute(&cus, hipDeviceAttributeMultiprocessorCount, dev) != hipSuccess) { grid = -1; return; }
        if (hipFuncSetAttribute((const void*)mk_fwd, hipFuncAttributeMaxDynamicSharedMemorySize, LDS_BYTES) != hipSuccess) { fprintf(stderr, "kernel_launch: hipFuncSetAttribute failed\n"); grid = -1; return; }
        if (hipOccupancyMaxActiveBlocksPerMultiprocessor(&per_cu, (const void*)mk_fwd, NTHR, LDS_BYTES) != hipSuccess || per_cu < 1) { fprintf(stderr, "kernel_launch: occupancy query says %d blocks per CU\n", per_cu); grid = -1; return; }
        if (cus != 256) { fprintf(stderr, "kernel_launch: built for a 256-CU device (unit-to-workgroup maps assume 256 workgroups), found %d\n", cus); grid = -1; return; }
        grid = cus;
    }
    if (grid < 0) return;
    (void)hipMemsetAsync((char*)d_ws + WS_CTL, 0, CTL_ZERO_BYTES, stream);
    Args a{};
    for (int i = 0; i < 29; ++i) a.in[i] = (const float*)d_in[i];
    a.out = (float*)d_out; a.ws = (unsigned char*)d_ws;
#if MK_PER_PHASE
    for (int ph = 0; ph < PH_TOTAL; ++ph) { a.ph_lo = ph; a.ph_hi = ph + 1; hipLaunchKernelGGL(mk_fwd, dim3(grid), dim3(NTHR), LDS_BYTES, stream, a);
#if MK_DIAG
        if (ph == DIAG_AFTER && DIAG_LEN > 0) hipLaunchKernelGGL(diag_sum, dim3(1024), dim3(256), 0, stream, (const unsigned*)((char*)d_ws + (size_t)DIAG_OFF * MiB), (size_t)DIAG_LEN * MiB / 4, (unsigned*)((char*)d_ws + WS_CTL) + 2048);
#endif
    }
#else
    a.ph_lo = 0; a.ph_hi = PH_TOTAL; hipLaunchKernelGGL(mk_fwd, dim3(grid), dim3(NTHR), LDS_BYTES, stream, a);
#endif
#if MK_DIAG
    { unsigned* ctl = (unsigned*)((char*)d_ws + WS_CTL); unsigned* pers = (unsigned*)((char*)d_ws + WS_CTL + 3 * (MiB / 2));
      if (DIAG_LEN == 0) hipLaunchKernelGGL(diag_sum, dim3(1024), dim3(256), 0, stream, (const unsigned*)d_out, (size_t)M * DM, ctl + 2048);
      hipLaunchKernelGGL(diag_cmp, dim3(1), dim3(256), 0, stream, (float*)d_out, (const unsigned*)(ctl + 2048), pers, (const unsigned*)(ctl + CW_BAR + XB_TMO)); }
#endif
}
```
